# Optimizing an MI355X kernel written in HIP

```python
import jax, jax.numpy as jnp
from jax import lax
import numpy as np

D_MODEL = 1024
BATCH = 8
SEQ = 2048
DEPTH = 1

PLE_DIM = 256
HEAD_DIM = 64
RWKV_HEADS = 8
RWKV_DIM = RWKV_HEADS * HEAD_DIM
DECAY_LORA = 64
ICLR_LORA = 64
GATE_LORA = 128
GN_EPS = 64e-5
ATTN_GROUPS = ((128, 1), (512, 4), (2048, 16))
HEADS_PER_GROUP = 4
ATTN_HEADS = HEADS_PER_GROUP * len(ATTN_GROUPS)
ATTN_DIM = ATTN_HEADS * HEAD_DIM
ATTN_OUT_DIM = HEADS_PER_GROUP * HEAD_DIM
BAND_BLOCK = 128
ROPE_THETA = 10000.0
NEG_INF = -1e30
D_FF = 2816
RMS_EPS = 1e-6
N_BRANCHES = 2
RWKV_COLS = 3 * RWKV_DIM + DECAY_LORA + ICLR_LORA + GATE_LORA
ATTN_COLS = 3 * ATTN_DIM
GATE_COLS = N_BRANCHES * D_MODEL
IN_COLS = RWKV_COLS + ATTN_COLS + GATE_COLS

kernel_name = 'hybrid_rwkv7_dilated_attn_macaron_block'


def rms_norm(x, gain):
    xf = x.astype(jnp.float32)
    y = xf * lax.rsqrt(jnp.mean(xf * xf, axis=-1, keepdims=True) + RMS_EPS)
    return (y * gain.astype(jnp.float32)).astype(x.dtype)


def swiglu(h, w_gate, w_up, w_down):
    return (jax.nn.silu(h @ w_gate) * (h @ w_up)) @ w_down


def token_shift(z):
    return jnp.pad(z, ((0, 0), (1, 0), (0, 0)))[:, :-1]


def apply_rope(x, cos, sin):
    x1, x2 = jnp.split(x.astype(jnp.float32), 2, axis=-1)
    return jnp.concatenate([x1 * cos - x2 * sin, x2 * cos + x1 * sin], axis=-1).astype(x.dtype)


def wkv7_scan(r, decay, k, v, kk, a):
    B, S, H, N = r.shape

    def step(state, inp):
        r_t, w_t, k_t, v_t, kk_t, a_t = inp
        sa = jnp.einsum('bhvk,bhk->bhv', state, -kk_t)
        state = (state * w_t[:, :, None, :]
                 + sa[..., None] * (kk_t * a_t)[:, :, None, :]
                 + v_t[..., None] * k_t[:, :, None, :])
        y_t = jnp.einsum('bhvk,bhk->bhv', state, r_t)
        return state, y_t

    xs = tuple(jnp.moveaxis(t, 1, 0) for t in (r, decay, k, v, kk, a))
    s0 = jnp.zeros((B, H, N, N), jnp.float32)
    _, y = lax.scan(step, s0, xs)
    return jnp.moveaxis(y, 0, 1)


def rwkv7_time_mix(z, mu, w0, w2, a0, a2, g2, k_k, k_a, r_k, gn_w, gn_b):
    B, S, _ = z.shape
    z = z + (token_shift(z) - z) * mu
    r, k, v, wd, ad, gd = jnp.split(
        z, [RWKV_DIM, 2 * RWKV_DIM, 3 * RWKV_DIM, 3 * RWKV_DIM + DECAY_LORA,
            3 * RWKV_DIM + DECAY_LORA + ICLR_LORA], axis=-1)
    w = -jax.nn.softplus(-(w0 + jnp.tanh(wd) @ w2)) - 0.5
    a = jax.nn.sigmoid(a0 + ad @ a2)
    g = jax.nn.sigmoid(gd) @ g2
    kk = k * k_k
    k = k * (1.0 + (a - 1.0) * k_a)

    def heads(t):
        return t.reshape(B, S, RWKV_HEADS, HEAD_DIM).astype(jnp.float32)

    kk = heads(kk)
    kk = kk * lax.rsqrt(jnp.maximum(jnp.sum(kk * kk, axis=-1, keepdims=True), 1e-24))
    decay = jnp.exp(-jnp.exp(heads(w)))
    r_h, k_h, v_h, a_h = heads(r), heads(k), heads(v), heads(a)
    y = wkv7_scan(r_h, decay, k_h, v_h, kk, a_h)
    mean = jnp.mean(y, axis=-1, keepdims=True)
    var = jnp.mean(jnp.square(y - mean), axis=-1, keepdims=True)
    y = ((y - mean) * lax.rsqrt(var + GN_EPS)).reshape(B, S, RWKV_DIM)
    y = y * gn_w.astype(jnp.float32) + gn_b.astype(jnp.float32)
    bonus = jnp.sum(r_h * k_h * r_k.astype(jnp.float32), axis=-1, keepdims=True) * v_h
    y = y + bonus.reshape(B, S, RWKV_DIM)
    return (y * g.astype(jnp.float32)).astype(z.dtype)


def banded_causal_attention(q, k, v, band):
    N, L, H, Dh = q.shape
    nb = -(-L // BAND_BLOCK)
    Lp = nb * BAND_BLOCK
    pad = Lp - L
    qb = jnp.pad(q, ((0, 0), (0, pad), (0, 0), (0, 0))).reshape(N, nb, BAND_BLOCK, H, Dh)

    def key_blocks(t):
        tp = jnp.pad(t, ((0, 0), (BAND_BLOCK, pad), (0, 0), (0, 0))).reshape(N, nb + 1, BAND_BLOCK, H, Dh)
        return jnp.concatenate([tp[:, :-1], tp[:, 1:]], axis=2)

    kb, vb = key_blocks(k), key_blocks(v)
    s = jnp.einsum('nbqhd,nbkhd->nbhqk', qb.astype(jnp.float32), kb.astype(jnp.float32)) * (Dh ** -0.5)
    blk = jnp.arange(nb)[:, None]
    qpos = blk * BAND_BLOCK + jnp.arange(BAND_BLOCK)[None, :]
    kpos = blk * BAND_BLOCK - BAND_BLOCK + jnp.arange(2 * BAND_BLOCK)[None, :]
    dist = qpos[:, :, None] - kpos[:, None, :]
    valid = (dist >= 0) & (dist <= band) & (kpos[:, None, :] >= 0)
    s = jnp.where(valid[None, :, None], s, NEG_INF)
    m = jnp.max(s, axis=-1, keepdims=True)
    e = jnp.exp(s - m)
    l = jnp.sum(e, axis=-1, keepdims=True)
    o = jnp.einsum('nbhqk,nbkhd->nbqhd', e, vb.astype(jnp.float32)) / jnp.swapaxes(l, 2, 3)
    lse = jnp.swapaxes((m + jnp.log(l))[..., 0], 2, 3)
    return o.reshape(N, Lp, H, Dh)[:, :L], lse.reshape(N, Lp, H)[:, :L]


def dilated_causal_attention(q, k, v, window, dilation):
    B, S, H, Dh = q.shape
    L = S // dilation

    def fold(t):
        return t.reshape(B, L, dilation, H, Dh).transpose(0, 2, 1, 3, 4).reshape(B * dilation, L, H, Dh)

    o, lse = banded_causal_attention(fold(q), fold(k), fold(v), window // dilation)
    o = o.reshape(B, dilation, L, H, Dh).transpose(0, 2, 1, 3, 4).reshape(B, S, H, Dh)
    lse = lse.reshape(B, dilation, L, H).transpose(0, 2, 1, 3).reshape(B, S, H)
    return o, lse


def dilated_attention_mix(z, cos, sin, q_gain, k_gain):
    B, S, _ = z.shape
    q, k, v = jnp.split(z, 3, axis=-1)
    q = q.reshape(B, S, ATTN_HEADS, HEAD_DIM)
    k = k.reshape(B, S, ATTN_HEADS, HEAD_DIM)
    v = v.reshape(B, S, ATTN_HEADS, HEAD_DIM)
    q = apply_rope(rms_norm(q, q_gain), cos, sin)
    k = apply_rope(rms_norm(k, k_gain), cos, sin)
    outs, lses = [], []
    for gi, (window, dilation) in enumerate(ATTN_GROUPS):
        hs = slice(gi * HEADS_PER_GROUP, (gi + 1) * HEADS_PER_GROUP)
        o, lse = dilated_causal_attention(q[:, :, hs], k[:, :, hs], v[:, :, hs], window, dilation)
        outs.append(o)
        lses.append(lse)
    wts = jax.nn.softmax(jnp.stack(lses, axis=0), axis=0)
    o = jnp.sum(wts[..., None] * jnp.stack(outs, axis=0), axis=0)
    return o.reshape(B, S, ATTN_OUT_DIM).astype(z.dtype)


def hybrid_layer(x, p_i, cos, sin, ffn1_norm, ffn1_w_gate, ffn1_w_up, ffn1_w_down, mix_norm, w_in,
                 rwkv_mu, rwkv_w0, rwkv_w2, rwkv_a0, rwkv_a2, rwkv_g2, rwkv_k_k, rwkv_k_a, rwkv_r_k,
                 rwkv_gn_w, rwkv_gn_b, q_norm, k_norm, w_br_rwkv, w_br_attn, w_out,
                 ffn2_norm, ffn2_w_gate, ffn2_w_up, ffn2_w_down, ple_norm, ple_w_gate, ple_w_proj):
    x = x + 0.5 * swiglu(rms_norm(x, ffn1_norm), ffn1_w_gate, ffn1_w_up, ffn1_w_down)
    h = rms_norm(x, mix_norm)
    z = h @ w_in
    z_rwkv, z_attn, z_gate = jnp.split(z, [RWKV_COLS, RWKV_COLS + ATTN_COLS], axis=-1)
    y_rwkv = rwkv7_time_mix(z_rwkv, rwkv_mu, rwkv_w0, rwkv_w2, rwkv_a0, rwkv_a2, rwkv_g2,
                            rwkv_k_k, rwkv_k_a, rwkv_r_k, rwkv_gn_w, rwkv_gn_b)
    y_attn = dilated_attention_mix(z_attn, cos, sin, q_norm, k_norm)
    g_rwkv, g_attn = jnp.split(jax.nn.sigmoid(z_gate), N_BRANCHES, axis=-1)
    merged = g_rwkv * (y_rwkv @ w_br_rwkv) + g_attn * (y_attn @ w_br_attn)
    x = x + merged @ w_out
    x = x + 0.5 * swiglu(rms_norm(x, ffn2_norm), ffn2_w_gate, ffn2_w_up, ffn2_w_down)
    x = x + jax.nn.sigmoid(rms_norm(x, ple_norm) @ ple_w_gate) * (p_i @ ple_w_proj)
    return x


def setup_inputs(seed: int = 0) -> dict:
    key = jax.random.key(seed)
    ks = jax.random.split(key, 40)
    f32 = jnp.float32

    def nrm(i, shape, scale):
        return jax.random.normal(ks[i], shape, f32) * scale

    def gain(i, shape):
        return 1.0 + 0.02 * jax.random.normal(ks[i], shape, f32)

    L = DEPTH
    return {
        'x': nrm(0, (BATCH, SEQ, D_MODEL), 1.0),
        'p': nrm(1, (DEPTH, BATCH, SEQ, PLE_DIM), 1.0),
        'positions': (jnp.arange(SEQ, dtype=jnp.int32)[None, :]
                      + jax.random.randint(ks[2], (BATCH, 1), 0, 4096, dtype=jnp.int32)),
        'ffn1_norm': gain(3, (L, D_MODEL)),
        'ffn1_w_gate': nrm(4, (L, D_MODEL, D_FF), D_MODEL ** -0.5),
        'ffn1_w_up': nrm(5, (L, D_MODEL, D_FF), D_MODEL ** -0.5),
        'ffn1_w_down': nrm(6, (L, D_FF, D_MODEL), D_FF ** -0.5),
        'mix_norm': gain(7, (L, D_MODEL)),
        'w_in': nrm(8, (L, D_MODEL, IN_COLS), D_MODEL ** -0.5),
        'rwkv_mu': jax.random.uniform(ks[9], (L, RWKV_COLS), f32),
        'rwkv_w0': -0.5 - 4.5 * jax.random.uniform(ks[10], (L, RWKV_DIM), f32),
        'rwkv_w2': nrm(11, (L, DECAY_LORA, RWKV_DIM), 0.1),
        'rwkv_a0': nrm(12, (L, RWKV_DIM), 0.1),
        'rwkv_a2': nrm(13, (L, ICLR_LORA, RWKV_DIM), 0.1),
        'rwkv_g2': nrm(14, (L, GATE_LORA, RWKV_DIM), GATE_LORA ** -0.5),
        'rwkv_k_k': 0.85 + nrm(15, (L, RWKV_DIM), 0.02),
        'rwkv_k_a': 1.0 + nrm(16, (L, RWKV_DIM), 0.02),
        'rwkv_r_k': nrm(17, (L, RWKV_HEADS, HEAD_DIM), 0.1),
        'rwkv_gn_w': gain(18, (L, RWKV_DIM)),
        'rwkv_gn_b': nrm(19, (L, RWKV_DIM), 0.01),
        'q_norm': gain(20, (L, HEAD_DIM)),
        'k_norm': gain(21, (L, HEAD_DIM)),
        'w_br_rwkv': nrm(22, (L, RWKV_DIM, D_MODEL), RWKV_DIM ** -0.5),
        'w_br_attn': nrm(23, (L, ATTN_OUT_DIM, D_MODEL), ATTN_OUT_DIM ** -0.5),
        'w_out': nrm(24, (L, D_MODEL, D_MODEL), D_MODEL ** -0.5),
        'ffn2_norm': gain(25, (L, D_MODEL)),
        'ffn2_w_gate': nrm(26, (L, D_MODEL, D_FF), D_MODEL ** -0.5),
        'ffn2_w_up': nrm(27, (L, D_MODEL, D_FF), D_MODEL ** -0.5),
        'ffn2_w_down': nrm(28, (L, D_FF, D_MODEL), D_FF ** -0.5),
        'ple_norm': gain(29, (L, D_MODEL)),
        'ple_w_gate': nrm(30, (L, D_MODEL, D_MODEL), D_MODEL ** -0.5),
        'ple_w_proj': nrm(31, (L, PLE_DIM, D_MODEL), PLE_DIM ** -0.5),
    }


def reference(x, p, positions, ffn1_norm, ffn1_w_gate, ffn1_w_up, ffn1_w_down, mix_norm, w_in,
              rwkv_mu, rwkv_w0, rwkv_w2, rwkv_a0, rwkv_a2, rwkv_g2, rwkv_k_k, rwkv_k_a, rwkv_r_k,
              rwkv_gn_w, rwkv_gn_b, q_norm, k_norm, w_br_rwkv, w_br_attn, w_out,
              ffn2_norm, ffn2_w_gate, ffn2_w_up, ffn2_w_down, ple_norm, ple_w_gate, ple_w_proj):
    inv_freq = 1.0 / (ROPE_THETA ** (jnp.arange(0, HEAD_DIM, 2, dtype=jnp.float32) / HEAD_DIM))
    ang = positions.astype(jnp.float32)[..., None] * inv_freq
    cos = jnp.cos(ang)[:, :, None, :]
    sin = jnp.sin(ang)[:, :, None, :]
    for i in range(DEPTH):
        x = hybrid_layer(x, p[i], cos, sin, ffn1_norm[i], ffn1_w_gate[i], ffn1_w_up[i], ffn1_w_down[i],
                         mix_norm[i], w_in[i], rwkv_mu[i], rwkv_w0[i], rwkv_w2[i], rwkv_a0[i], rwkv_a2[i],
                         rwkv_g2[i], rwkv_k_k[i], rwkv_k_a[i], rwkv_r_k[i], rwkv_gn_w[i], rwkv_gn_b[i],
                         q_norm[i], k_norm[i], w_br_rwkv[i], w_br_attn[i], w_out[i],
                         ffn2_norm[i], ffn2_w_gate[i], ffn2_w_up[i], ffn2_w_down[i],
                         ple_norm[i], ple_w_gate[i], ple_w_proj[i])
    return x
```

```cpp
#include <hip/hip_runtime.h>
#include <cstdio>
#include <cstdint>

#ifndef MK_ONE_LAUNCH
#define MK_ONE_LAUNCH 0
#endif

#define LAS __attribute__((address_space(3)))
#define GAS __attribute__((address_space(1)))
typedef unsigned short bf16_t;
typedef short bf16x8 __attribute__((ext_vector_type(8)));
typedef short s16x4 __attribute__((ext_vector_type(4)));
typedef float f32x4 __attribute__((ext_vector_type(4)));
typedef float f32x2 __attribute__((ext_vector_type(2)));
typedef float f32x16 __attribute__((ext_vector_type(16)));
typedef unsigned u32x4 __attribute__((ext_vector_type(4)));
typedef unsigned u32x2 __attribute__((ext_vector_type(2)));
typedef __bf16 bf16x2_t __attribute__((ext_vector_type(2)));

__device__ __forceinline__ unsigned pk2(float lo, float hi) { f32x2 v = {lo, hi}; bf16x2_t b = __builtin_convertvector(v, bf16x2_t); return __builtin_bit_cast(unsigned, b); }
__device__ __forceinline__ float bflo(unsigned w) { return __uint_as_float(w << 16); }
__device__ __forceinline__ float bfhi(unsigned w) { return __uint_as_float(w & 0xffff0000u); }
__device__ __forceinline__ float fast_exp(float x) { return __builtin_amdgcn_exp2f(x * 1.4426950408889634f); }
__device__ __forceinline__ float fast_sigmoid(float x) { return __builtin_amdgcn_rcpf(1.0f + __builtin_amdgcn_exp2f(-x * 1.4426950408889634f)); }

constexpr int NB = 8, SEQ = 2048, T = NB * SEQ, DM = 1024, FF = 2816, NIN = 6144, PLE = 256;
constexpr int RWD = 512, RWC = 1792, NAH = 12, HD = 64, YC = 768;
constexpr float RMS_EPS = 1e-6f, GN_EPS = 64e-5f;
constexpr float QSCALE = 0.125f * 1.4426950408889634f;

constexpr size_t MiB = 1u << 20;
constexpr size_t WS_CTL = 0, CTL_ZERO_BYTES = 64 * 1024;
constexpr size_t WS_SSQ = 1 * MiB;
constexpr size_t WS_COS = 2 * MiB, WS_SIN = 4 * MiB;
constexpr size_t WS_LORA = 6 * MiB;
constexpr size_t WS_ATL = 7 * MiB;
constexpr size_t WS_WIN = 8 * MiB;
constexpr size_t WS_WBRA = 20 * MiB, WS_WBRB = 21 * MiB, WS_WOUT = 22 * MiB;
constexpr size_t WS_XB = 24 * MiB;
constexpr size_t WS_C = 56 * MiB;
constexpr size_t WS_GATE = 128 * MiB;
constexpr size_t WS_D = 192 * MiB;
constexpr size_t WS_W1CAT = WS_D, WS_W1D = WS_D + 11 * MiB;
constexpr size_t WS_W2CAT = WS_D, WS_W2D = WS_D + 11 * MiB, WS_WPG = WS_D + 17 * MiB, WS_WPP = WS_D + 19 * MiB, WS_PB = WS_D + 20 * MiB;
constexpr size_t WS_END = 256 * MiB;
constexpr size_t QKV_SEC = (size_t)NB * NAH * SEQ * HD;

constexpr int RING_BYTES = 131072, MISC_OFF = RING_BYTES + 320, LDS_BYTES = 147456;
constexpr int NWAVES = 8;
namespace pg8 {
#define PG8_LAS __attribute__((address_space(3)))
constexpr int BM = 256, BK = 64, HALF = 128, HTB = HALF * BK * 2  , STAGE_BYTES = 8 * HTB, NXCD = 8, WGM = 8;

__host__ __device__ __forceinline__ int lds_byte(int r, int c) { const int st = (r >> 4) * 2 + (c >> 5), rr = r & 15, cc = c & 31, ob = rr * 64 + cc * 2; return st * 1024 + (ob ^ (((ob >> 9) & 1) << 5)); }
__host__ __device__ __forceinline__ void stage_rc(int b, int& R, int& C) { const int st = b / 1024, sb = b % 1024, swz = sb ^ (((sb >> 9) & 1) << 5); R = (st >> 1) * 16 + swz / 64; C = (st & 1) * 32 + (swz % 64) / 2; }
__host__ __device__ __forceinline__ int perm32(int rho) { const int n = rho >> 4, i = rho & 15; return 8 * (i >> 2) + 4 * n + (i & 3); }

struct Unit { int pm, pn; };
struct Gemm { const bf16_t* A; const bf16_t* Bt; int lda, ldb, M, N, K; };

struct StaticOrder {
    int nM, nN, nwg, G, c;
    __host__ __device__ void init(int M, int N, int G_, int c_) { nM = M / BM; nN = N / BM; nwg = nM * nN; G = G_; c = c_; }
    __host__ __device__ bool next(int i, Unit& u) const {
        const long L = (long)i * G + c; if (L >= nwg) return false;
        int wgid = (int)L; { const int q = nwg / NXCD, r = nwg % NXCD, xcd = wgid % NXCD, off = wgid / NXCD; wgid = (xcd < r ? xcd * (q + 1) : r * (q + 1) + (xcd - r) * q) + off; }
        const int nig = WGM * nN, gid = wgid / nig, fm = gid * WGM, gsz = (nM - fm) < WGM ? (nM - fm) : WGM;
        u.pm = fm + ((wgid % nig) % gsz); u.pn = (wgid % nig) / gsz; return true;
    }
    __device__ __forceinline__ void a_ready(const Unit&) const {}
    __device__ __forceinline__ void done(const Unit&) const {}
};


typedef f32x4 Acc[2][2][4][2];

__device__ __forceinline__ float load_rs1(const float* ssq, int row, int fq) {
    const f32x4 v = *(const f32x4*)(ssq + (size_t)row * 16 + 4 * fq);
    float s = (v[0] + v[1]) + (v[2] + v[3]);
    s += __shfl_xor(s, 16); s += __shfl_xor(s, 32);
    return 1.0f / sqrtf(s * (1.0f / DM) + RMS_EPS);
}
__device__ __forceinline__ float silu_mul(float g, float u) { return g * fast_sigmoid(g) * u; }

struct EpiSwiglu {
    static constexpr bool PERM = true, AFTER_DRAIN = false;
    bf16_t* H; const float* ssq;
    __device__ __forceinline__ void operator()(const Acc& acc, const Unit& u, int wr, int wc, int fr, int fq) const {
        const int row0 = u.pm * BM + wr * 64 + fr, col0 = u.pn * HALF + wc * 32 + 8 * fq;
#pragma unroll
        for (int ai = 0; ai < 2; ++ai)
#pragma unroll
            for (int m = 0; m < 4; ++m) {
                const float r = load_rs1(ssq, row0 + ai * HALF + m * 16, fq);
                const f32x4 g0 = acc[ai][0][m][0] * r, g1 = acc[ai][0][m][1] * r, u0 = acc[ai][1][m][0] * r, u1 = acc[ai][1][m][1] * r;
                u32x4 w;
                w[0] = pk2(silu_mul(g0[0], u0[0]), silu_mul(g0[1], u0[1])); w[1] = pk2(silu_mul(g0[2], u0[2]), silu_mul(g0[3], u0[3]));
                w[2] = pk2(silu_mul(g1[0], u1[0]), silu_mul(g1[1], u1[1])); w[3] = pk2(silu_mul(g1[2], u1[2]), silu_mul(g1[3], u1[3]));
                *(u32x4*)(H + (size_t)(row0 + ai * HALF + m * 16) * FF + col0) = w;
                if (m & 1) asm volatile("" ::: "memory");
            }
    }
};

struct EpiResid {
    static constexpr bool PERM = false, AFTER_DRAIN = false;
    const float* xold; float* xnew; bf16_t* xb; float* ssq; float coef;
    __device__ __forceinline__ void operator()(const Acc& acc, const Unit& u, int wr, int wc, int fr, int fq) const {
        const int row0 = u.pm * BM + wr * 64 + fr, col0 = u.pn * BM + wc * 32 + 4 * fq;
#pragma unroll
        for (int ai = 0; ai < 2; ++ai)
#pragma unroll
            for (int m = 0; m < 4; ++m) {
                const int row = row0 + ai * HALF + m * 16; const size_t off = (size_t)row * DM + col0; float s = 0.f;
#pragma unroll
                for (int bj = 0; bj < 2; ++bj)
#pragma unroll
                    for (int n = 0; n < 2; ++n) {
                        const size_t o = off + bj * HALF + n * 16;
                        const f32x4 v = *(const f32x4*)(xold + o) + acc[ai][bj][m][n] * coef;
                        *(f32x4*)(xnew + o) = v; s += (v[0] * v[0] + v[1] * v[1]) + (v[2] * v[2] + v[3] * v[3]);
                        u32x2 w; w[0] = pk2(v[0], v[1]); w[1] = pk2(v[2], v[3]); *(u32x2*)(xb + o) = w;
                    }
                s += __shfl_xor(s, 16); s += __shfl_xor(s, 32);
                if (fq == 0) ssq[(size_t)row * 16 + 4 * u.pn + wc] = s;
                if (m & 1) asm volatile("" ::: "memory");
            }
    }
};

struct EpiWin {
    static constexpr bool PERM = true, AFTER_DRAIN = false;
    const float* ssq; bf16_t* zr; bf16_t* qkv; bf16_t* gates; const float* cosT; const float* sinT; const float* qg; const float* kg;
    __device__ __forceinline__ void operator()(const Acc& acc, const Unit& u, int wr, int wc, int fr, int fq) const {
        const int row0 = u.pm * BM + wr * 64 + fr, pn = u.pn;
        if (pn < 7) {
            const int col0 = pn * BM + wc * 32 + 8 * fq;
#pragma unroll
            for (int ai = 0; ai < 2; ++ai)
#pragma unroll
                for (int m = 0; m < 4; ++m) { const float r = load_rs1(ssq, row0 + ai * HALF + m * 16, fq); bf16_t* rowp = zr + (size_t)(row0 + ai * HALF + m * 16) * RWC + col0;
#pragma unroll
                    for (int bj = 0; bj < 2; ++bj) { const f32x4 v0 = acc[ai][bj][m][0] * r, v1 = acc[ai][bj][m][1] * r;
                        u32x4 w; w[0] = pk2(v0[0], v0[1]); w[1] = pk2(v0[2], v0[3]); w[2] = pk2(v1[0], v1[1]); w[3] = pk2(v1[2], v1[3]);
                        *(u32x4*)(rowp + bj * HALF) = w; }
                    if (m & 1) asm volatile("" ::: "memory"); }
        } else if (pn < 16) {
            const int sec = (pn - 7) / 3, g = (pn - 7) - 3 * sec, hh = 4 * g + wc, sh = 2 * g;
            bf16_t* secp = qkv + (size_t)sec * QKV_SEC;
            f32x4 gn[2][2];
            if (sec < 2) { const float* gp = sec == 0 ? qg : kg;
#pragma unroll
                for (int bj = 0; bj < 2; ++bj)
#pragma unroll
                    for (int n = 0; n < 2; ++n) gn[bj][n] = *(const f32x4*)(gp + 32 * bj + 8 * fq + 4 * n); }
            const float osc = sec == 0 ? QSCALE : 1.0f;
#pragma unroll
            for (int ai = 0; ai < 2; ++ai)
#pragma unroll
                for (int m = 0; m < 4; ++m) {
                    const int row = row0 + ai * HALF + m * 16; const float r = load_rs1(ssq, row0 + ai * HALF + m * 16, fq);
                    const int b = row >> 11, s = row & 2047, idx = ((s & ((1 << sh) - 1)) << (11 - sh)) + (s >> sh);
                    bf16_t* dst = secp + ((size_t)(b * NAH + hh) * SEQ + idx) * HD + 8 * fq;
                    f32x4 v[2][2];
#pragma unroll
                    for (int bj = 0; bj < 2; ++bj)
#pragma unroll
                        for (int n = 0; n < 2; ++n) v[bj][n] = acc[ai][bj][m][n] * r;
                    if (sec < 2) {
                        float ss = 0.f;
#pragma unroll
                        for (int bj = 0; bj < 2; ++bj)
#pragma unroll
                            for (int n = 0; n < 2; ++n) ss += (v[bj][n][0] * v[bj][n][0] + v[bj][n][1] * v[bj][n][1]) + (v[bj][n][2] * v[bj][n][2] + v[bj][n][3] * v[bj][n][3]);
                        ss += __shfl_xor(ss, 16); ss += __shfl_xor(ss, 32);
                        const float inv = osc / sqrtf(ss * (1.0f / HD) + RMS_EPS);
#pragma unroll
                        for (int n = 0; n < 2; ++n) {
                            const f32x4 c = *(const f32x4*)(cosT + (size_t)row * 32 + 8 * fq + 4 * n), sn = *(const f32x4*)(sinT + (size_t)row * 32 + 8 * fq + 4 * n);
                            const f32x4 y0 = v[0][n] * gn[0][n] * inv, y1 = v[1][n] * gn[1][n] * inv;
                            v[0][n] = y0 * c - y1 * sn; v[1][n] = y1 * c + y0 * sn;
                        }
                    }
#pragma unroll
                    for (int bj = 0; bj < 2; ++bj) { u32x4 w; w[0] = pk2(v[bj][0][0], v[bj][0][1]); w[1] = pk2(v[bj][0][2], v[bj][0][3]); w[2] = pk2(v[bj][1][0], v[bj][1][1]); w[3] = pk2(v[bj][1][2], v[bj][1][3]);
                        *(u32x4*)(dst + 32 * bj) = w; }
                    asm volatile("" ::: "memory");
                }
        } else {
            const int col0 = (pn - 16) * BM + wc * 32 + 8 * fq;
#pragma unroll
            for (int ai = 0; ai < 2; ++ai)
#pragma unroll
                for (int m = 0; m < 4; ++m) { const float r = load_rs1(ssq, row0 + ai * HALF + m * 16, fq); bf16_t* rowp = gates + (size_t)(row0 + ai * HALF + m * 16) * 2048 + col0;
#pragma unroll
                    for (int bj = 0; bj < 2; ++bj) { const f32x4 v0 = acc[ai][bj][m][0] * r, v1 = acc[ai][bj][m][1] * r;
                        u32x4 w; w[0] = pk2(fast_sigmoid(v0[0]), fast_sigmoid(v0[1])); w[1] = pk2(fast_sigmoid(v0[2]), fast_sigmoid(v0[3]));
                        w[2] = pk2(fast_sigmoid(v1[0]), fast_sigmoid(v1[1])); w[3] = pk2(fast_sigmoid(v1[2]), fast_sigmoid(v1[3]));
                        *(u32x4*)(rowp + bj * HALF) = w; }
                    if (m & 1) asm volatile("" ::: "memory"); }
        }
    }
};

struct EpiGateBf16 {
    static constexpr bool PERM = true, AFTER_DRAIN = false;
    bf16_t* O; const bf16_t* gate; int goff; const bf16_t* addp;
    __device__ __forceinline__ void operator()(const Acc& acc, const Unit& u, int wr, int wc, int fr, int fq) const {
        const int row0 = u.pm * BM + wr * 64 + fr, col0 = u.pn * BM + wc * 32 + 8 * fq;
#pragma unroll
        for (int ai = 0; ai < 2; ++ai)
#pragma unroll
            for (int m = 0; m < 4; ++m) {
                const int row = row0 + ai * HALF + m * 16;
#pragma unroll
                for (int bj = 0; bj < 2; ++bj) {
                    f32x4 v0 = acc[ai][bj][m][0], v1 = acc[ai][bj][m][1];
                    if (gate) { const u32x4 gq = *(const u32x4*)(gate + (size_t)row * 2048 + goff + col0 + bj * HALF);
                        v0[0] *= bflo(gq[0]); v0[1] *= bfhi(gq[0]); v0[2] *= bflo(gq[1]); v0[3] *= bfhi(gq[1]); v1[0] *= bflo(gq[2]); v1[1] *= bfhi(gq[2]); v1[2] *= bflo(gq[3]); v1[3] *= bfhi(gq[3]); }
                    if (addp) { const u32x4 aq = *(const u32x4*)(addp + (size_t)row * DM + col0 + bj * HALF);
                        v0[0] += bflo(aq[0]); v0[1] += bfhi(aq[0]); v0[2] += bflo(aq[1]); v0[3] += bfhi(aq[1]); v1[0] += bflo(aq[2]); v1[1] += bfhi(aq[2]); v1[2] += bflo(aq[3]); v1[3] += bfhi(aq[3]); }
                    u32x4 w; w[0] = pk2(v0[0], v0[1]); w[1] = pk2(v0[2], v0[3]); w[2] = pk2(v1[0], v1[1]); w[3] = pk2(v1[2], v1[3]);
                    *(u32x4*)(O + (size_t)row * DM + col0 + bj * HALF) = w;
                }
                if (m & 1) asm volatile("" ::: "memory");
            }
    }
};

struct EpiPle {
    static constexpr bool PERM = false, AFTER_DRAIN = false;
    const float* xold; float* out; const float* ssq; const bf16_t* pp;
    __device__ __forceinline__ void operator()(const Acc& acc, const Unit& u, int wr, int wc, int fr, int fq) const {
        const int row0 = u.pm * BM + wr * 64 + fr, col0 = u.pn * BM + wc * 32 + 4 * fq;
#pragma unroll
        for (int ai = 0; ai < 2; ++ai)
#pragma unroll
            for (int m = 0; m < 4; ++m) {
                const int row = row0 + ai * HALF + m * 16; const size_t off = (size_t)row * DM + col0; const float r = load_rs1(ssq, row0 + ai * HALF + m * 16, fq);
#pragma unroll
                for (int bj = 0; bj < 2; ++bj)
#pragma unroll
                    for (int n = 0; n < 2; ++n) {
                        const size_t o = off + bj * HALF + n * 16;
                        const u32x2 pq = *(const u32x2*)(pp + o); const f32x4 a = acc[ai][bj][m][n] * r; f32x4 v = *(const f32x4*)(xold + o);
                        v[0] += fast_sigmoid(a[0]) * bflo(pq[0]); v[1] += fast_sigmoid(a[1]) * bfhi(pq[0]); v[2] += fast_sigmoid(a[2]) * bflo(pq[1]); v[3] += fast_sigmoid(a[3]) * bfhi(pq[1]);
                        *(f32x4*)(out + o) = v;
                    }
                if (m & 1) asm volatile("" ::: "memory");
            }
    }
};
template <class Epi, class Sched, bool ALIGN_EPI = false, bool SP2 = false>
__device__ __forceinline__ void gemm_phase(PG8_LAS unsigned char* lds, const Gemm g, const Sched& S, const Epi& E) {
    const int tid = threadIdx.x, wid = __builtin_amdgcn_readfirstlane(tid >> 6), lane = tid & 63, wr = wid >> 2, wc = wid & 3, fr = lane & 15, fq = lane >> 4;
    const int K = g.K, nt = K / BK;
    unsigned voffA[2], voffB[2];
#pragma unroll
    for (int i = 0; i < 2; ++i) { int R, C; stage_rc(tid * 16 + i * 8192, R, C); const int Rb = Epi::PERM ? ((R & ~31) + perm32(R & 31)) : R;
        voffA[i] = (unsigned)(R * g.lda + C) * 2u; voffB[i] = (unsigned)(Rb * g.ldb + C) * 2u; }
    const size_t kstep = (size_t)(BK * 2);
    const size_t hstepA = (size_t)HALF * g.lda * 2, hstepB = (size_t)HALF * g.ldb * 2;
    const size_t tstepA = 2 * hstepA, tstepB = 2 * hstepB;
    const unsigned ldsw = (unsigned)wid * 1024u;
    const int aoff = lds_byte(wr * 64 + fr, fq * 8), boff = lds_byte(wc * 32 + fr, fq * 8);
#define PG8_SA(b, h) (((b) * 2 + (h)) * HTB)
#define PG8_SB(b, h) ((4 + (b) * 2 + (h)) * HTB)
#define PG8_STAGE(bufoff, gbase, voff) do { _Pragma("unroll") for (int _i = 0; _i < 2; ++_i) \
        __builtin_amdgcn_global_load_lds((const unsigned*)((const char*)(gbase) + (voff)[_i]), (PG8_LAS unsigned*)(lds + (bufoff) + ldsw + _i * 8192), 16, 0, 0); } while (0)
#define PG8_LDA(dst, b, h) do { _Pragma("unroll") for (int m = 0; m < 4; ++m) _Pragma("unroll") for (int k = 0; k < 2; ++k) dst[m][k] = *(const PG8_LAS bf16x8*)(lds + PG8_SA(b, h) + aoff + m * 2048 + k * 1024); } while (0)
#define PG8_LDB(dst, b, h) do { _Pragma("unroll") for (int n = 0; n < 2; ++n) _Pragma("unroll") for (int k = 0; k < 2; ++k) dst[n][k] = *(const PG8_LAS bf16x8*)(lds + PG8_SB(b, h) + boff + n * 2048 + k * 1024); } while (0)
#define PG8_MMA(ai, bj, At, Bt) do { __builtin_amdgcn_s_setprio(1); _Pragma("unroll") for (int m = 0; m < 4; ++m) _Pragma("unroll") for (int n = 0; n < 2; ++n) _Pragma("unroll") for (int k = 0; k < 2; ++k) \
        acc[ai][bj][m][n] = __builtin_amdgcn_mfma_f32_16x16x32_bf16(Bt[n][k], At[m][k], acc[ai][bj][m][n], 0, 0, 0); __builtin_amdgcn_s_setprio(0); } while (0)
#define PG8_WAIT_V(n) asm volatile("s_waitcnt vmcnt(" #n ")" ::: "memory")
#define PG8_WAIT_L(n) asm volatile("s_waitcnt lgkmcnt(" #n ")" ::: "memory")
#define PG8_BAR __builtin_amdgcn_s_barrier()
#define PG8_SCHED __builtin_amdgcn_sched_barrier(0)
    Unit cur, nxt; int ui = 0;
    if (!S.next(0, cur)) return;
    f32x4 acc[2][2][4][2];
#pragma unroll
    for (int a = 0; a < 2; ++a)
#pragma unroll
        for (int b = 0; b < 2; ++b)
#pragma unroll
            for (int m = 0; m < 4; ++m)
#pragma unroll
                for (int n = 0; n < 2; ++n) acc[a][b][m][n] = (f32x4){0.f, 0.f, 0.f, 0.f};
    bf16x8 At[4][2], B0[2][2], B1[2][2];
    const char* cA = (const char*)g.A + (size_t)cur.pm * tstepA; const char* cB = (const char*)g.Bt + (size_t)cur.pn * tstepB;
    S.a_ready(cur);
    if constexpr (SP2) {
        PG8_STAGE(PG8_SB(0, 0), cB, voffB); PG8_STAGE(PG8_SB(0, 1), cB + hstepB, voffB); PG8_STAGE(PG8_SA(0, 0), cA, voffA); PG8_STAGE(PG8_SA(0, 1), cA + hstepA, voffA);
        if (wr == 1) PG8_BAR;
        PG8_WAIT_V(2); PG8_BAR;
        PG8_STAGE(PG8_SB(1, 0), cB + kstep, voffB); PG8_STAGE(PG8_SA(1, 0), cA + kstep, voffA); PG8_STAGE(PG8_SB(1, 1), cB + hstepB + kstep, voffB);
        PG8_WAIT_V(6); PG8_BAR;
    } else {
        PG8_STAGE(PG8_SB(0, 0), cB, voffB); PG8_STAGE(PG8_SA(0, 0), cA, voffA); PG8_STAGE(PG8_SB(0, 1), cB + hstepB, voffB); PG8_STAGE(PG8_SA(0, 1), cA + hstepA, voffA);
        if (wr == 1) PG8_BAR;
        PG8_WAIT_V(4); PG8_BAR;
        PG8_STAGE(PG8_SB(1, 0), cB + kstep, voffB); PG8_STAGE(PG8_SA(1, 0), cA + kstep, voffA); PG8_STAGE(PG8_SB(1, 1), cB + hstepB + kstep, voffB);
        PG8_WAIT_V(6); PG8_BAR;
    }
    for (;;) {
        const bool has_next = S.next(ui + 1, nxt);
        const char* nA = has_next ? (const char*)g.A + (size_t)nxt.pm * tstepA : cA; const char* nB = has_next ? (const char*)g.Bt + (size_t)nxt.pn * tstepB : cB;
        for (int t = 0; t < nt; t += 2) {
            const bool last = (t == nt - 2);
            const char* a1 = cA + (size_t)(t + 1) * kstep;
            const char* a2 = last ? nA : cA + (size_t)(t + 2) * kstep; const char* b2 = last ? nB : cB + (size_t)(t + 2) * kstep;
            const char* a3 = a2 + kstep; const char* b3 = b2 + kstep;
            if (last && has_next) S.a_ready(nxt);
            if constexpr (SP2) {
            PG8_LDB(B0, 0, 0); PG8_LDB(B1, 0, 1); PG8_SCHED; PG8_LDA(At, 0, 0); PG8_STAGE(PG8_SA(1, 1), a1 + hstepA, voffA);
            PG8_WAIT_V(8); PG8_WAIT_L(0); PG8_BAR; PG8_MMA(0, 0, At, B0); PG8_MMA(0, 1, At, B1); PG8_BAR; PG8_SCHED;
            PG8_LDA(At, 0, 1); PG8_STAGE(PG8_SB(0, 0), b2, voffB); PG8_STAGE(PG8_SB(0, 1), b2 + hstepB, voffB); PG8_STAGE(PG8_SA(0, 0), a2, voffA);
            PG8_WAIT_V(8); PG8_WAIT_L(0); PG8_BAR; PG8_MMA(1, 0, At, B0); PG8_MMA(1, 1, At, B1); PG8_BAR; PG8_SCHED;
            PG8_LDB(B0, 1, 0); PG8_LDB(B1, 1, 1); PG8_SCHED; PG8_LDA(At, 1, 0); PG8_STAGE(PG8_SA(0, 1), a2 + hstepA, voffA);
            PG8_WAIT_V(8); PG8_WAIT_L(0); PG8_BAR; PG8_MMA(0, 0, At, B0); PG8_MMA(0, 1, At, B1); PG8_BAR; PG8_SCHED;
            PG8_LDA(At, 1, 1); PG8_STAGE(PG8_SB(1, 0), b3, voffB); PG8_STAGE(PG8_SB(1, 1), b3 + hstepB, voffB); PG8_STAGE(PG8_SA(1, 0), a3, voffA);
            PG8_WAIT_V(8); PG8_WAIT_L(0); PG8_BAR; PG8_MMA(1, 0, At, B0); PG8_MMA(1, 1, At, B1); PG8_BAR; PG8_SCHED;
            } else {
            PG8_LDB(B0, 0, 0); PG8_SCHED; PG8_LDA(At, 0, 0); PG8_STAGE(PG8_SA(1, 1), a1 + hstepA, voffA);
            PG8_WAIT_L(8); PG8_BAR; PG8_WAIT_L(0); PG8_MMA(0, 0, At, B0); PG8_BAR; PG8_SCHED;
            PG8_LDB(B1, 0, 1); PG8_STAGE(PG8_SB(0, 0), b2, voffB);
            PG8_BAR; PG8_WAIT_L(0); PG8_MMA(0, 1, At, B1); PG8_BAR;
            PG8_LDA(At, 0, 1); PG8_STAGE(PG8_SA(0, 0), a2, voffA);
            PG8_BAR; PG8_WAIT_L(0); PG8_MMA(1, 0, At, B0); PG8_BAR; PG8_SCHED;
            PG8_STAGE(PG8_SB(0, 1), b2 + hstepB, voffB);
            PG8_WAIT_V(6); PG8_BAR; PG8_MMA(1, 1, At, B1); PG8_BAR;
            PG8_LDB(B0, 1, 0); PG8_SCHED; PG8_LDA(At, 1, 0); PG8_STAGE(PG8_SA(0, 1), a2 + hstepA, voffA);
            PG8_WAIT_L(8); PG8_BAR; PG8_WAIT_L(0); PG8_MMA(0, 0, At, B0); PG8_BAR; PG8_SCHED;
            PG8_LDB(B1, 1, 1); PG8_STAGE(PG8_SB(1, 0), b3, voffB);
            PG8_BAR; PG8_WAIT_L(0); PG8_MMA(0, 1, At, B1); PG8_BAR;
            PG8_LDA(At, 1, 1); PG8_STAGE(PG8_SA(1, 0), a3, voffA);
            PG8_BAR; PG8_WAIT_L(0); PG8_MMA(1, 0, At, B0); PG8_BAR; PG8_SCHED;
            PG8_STAGE(PG8_SB(1, 1), b3 + hstepB, voffB);
            PG8_WAIT_V(6); PG8_BAR; PG8_MMA(1, 1, At, B1); PG8_BAR;
            }
        }
        if constexpr (ALIGN_EPI) { if (wr == 0) PG8_BAR; }
        if constexpr (!Epi::AFTER_DRAIN) { E(acc, cur, wr, wc, fr, fq); S.done(cur); }
        if (!has_next) break;
#pragma unroll
        for (int a = 0; a < 2; ++a)
#pragma unroll
            for (int b = 0; b < 2; ++b)
#pragma unroll
                for (int m = 0; m < 4; ++m)
#pragma unroll
                    for (int n = 0; n < 2; ++n) acc[a][b][m][n] = (f32x4){0.f, 0.f, 0.f, 0.f};
        cur = nxt; cA = nA; cB = nB; ++ui;
        if constexpr (ALIGN_EPI) { if (wr == 1) PG8_BAR; }
    }
    PG8_WAIT_V(0);
    if constexpr (!ALIGN_EPI) { if (wr == 0) PG8_BAR; }
    PG8_BAR;
    if constexpr (Epi::AFTER_DRAIN) { E.fused(acc, cur, wr, wc, fr, fq, lds, wid, lane); S.done(cur); }
#undef PG8_SA
#undef PG8_SB
#undef PG8_STAGE
#undef PG8_LDA
#undef PG8_LDB
#undef PG8_MMA
#undef PG8_WAIT_V
#undef PG8_WAIT_L
#undef PG8_BAR
#undef PG8_SCHED
}
}

#define XB_TMO      128
#define XB_XCNT(j)  (256  + 64 * (j))
#define XB_XSUB(j)  (1280 + 64 * (j))
#define XB_XGEN(j)  (2304 + 64 * (j))
#define XB_TOP      3328
#define XB_TOPGEN   3392
#define XCD_BAR_WORDS 3456
#define XB_SPIN_CAP (1u << 18)

__device__ __forceinline__ unsigned xb_ld(unsigned* p)              { return __hip_atomic_load(p, __ATOMIC_RELAXED, __HIP_MEMORY_SCOPE_AGENT); }
__device__ __forceinline__ unsigned xb_add(unsigned* p, unsigned v) { return __hip_atomic_fetch_add(p, v, __ATOMIC_RELAXED, __HIP_MEMORY_SCOPE_AGENT); }
__device__ __forceinline__ unsigned xb_xcc_id() { return (unsigned)__builtin_amdgcn_s_getreg((3 << 11) | 20) & 0xFu; }
#define XB_SPIN(cond, bar) do { unsigned _sp = 0; while (cond) { __builtin_amdgcn_s_sleep(1); \
    if ((++_sp & 255u) == 0u) { if (xb_ld(&(bar)[XB_TMO])) break; if (_sp > XB_SPIN_CAP) { atomicAdd(&(bar)[XB_TMO], 1u); break; } } } } while (0)

struct XcdBarrier {
    unsigned* bar; unsigned x;
    volatile LAS unsigned* st;
};

__device__ __forceinline__ XcdBarrier xcd_barrier_post(unsigned* bar, volatile LAS unsigned* st) {
    XcdBarrier b; b.bar = bar; b.x = xb_xcc_id(); b.st = st;
    if (threadIdx.x == 0) (void)xb_add(&bar[XB_XCNT(b.x)], 1u);
    return b;
}
__device__ __forceinline__ void xcd_barrier_complete(unsigned* bar, unsigned x, unsigned& nloc, unsigned& nx) {
    const unsigned G = gridDim.x * gridDim.y * gridDim.z;
    unsigned sum, cnt, mine, sp = 0u;
    for (;;) {
        sum = 0u; cnt = 0u; mine = 0u;
#pragma unroll
        for (unsigned j = 0; j < 16; ++j) { const unsigned c = xb_ld(&bar[XB_XCNT(j)]); sum += c; cnt += (c > 0u) ? 1u : 0u; mine = (j == x) ? c : mine; }
        if (sum == G) break;
        __builtin_amdgcn_s_sleep(1);
        if ((++sp & 255u) == 0u) { if (xb_ld(&bar[XB_TMO])) break; if (sp > XB_SPIN_CAP) { atomicAdd(&bar[XB_TMO], 1u); break; } }
    }
    nloc = mine > 0u ? mine : 1u; nx = cnt > 0u ? cnt : 1u;
}

__device__ __forceinline__ void xcd_barrier(const XcdBarrier& b) {
    asm volatile("s_waitcnt vmcnt(0)" ::: "memory");
    __syncthreads();
    if (threadIdx.x == 0) {
        unsigned* bar = b.bar;
        __builtin_amdgcn_s_waitcnt(0);
        unsigned nloc = b.st[0], nx = b.st[1];
        if (nloc == 0u) { xcd_barrier_complete(bar, b.x, nloc, nx); b.st[0] = nloc; b.st[1] = nx; }
        const unsigned old = xb_add(&bar[XB_XSUB(b.x)], 1u);
        const unsigned gen = old / nloc;
        if (old + 1u == (gen + 1u) * nloc) {
            __builtin_amdgcn_fence(__ATOMIC_RELEASE, "agent");
            asm volatile("s_waitcnt vmcnt(0)" ::: "memory");
            const unsigned og = xb_add(&bar[XB_TOP], 1u);
            const unsigned tg = og / nx;
            if (og + 1u == (tg + 1u) * nx) xb_add(&bar[XB_TOPGEN], 1u);
            else XB_SPIN(xb_ld(&bar[XB_TOPGEN]) == tg, bar);
            __builtin_amdgcn_fence(__ATOMIC_ACQUIRE, "agent");
            xb_add(&bar[XB_XGEN(b.x)], 1u);
            asm volatile("s_waitcnt vmcnt(0)" ::: "memory");
        } else {
            XB_SPIN(xb_ld(&bar[XB_XGEN(b.x)]) == gen, bar);
            __builtin_amdgcn_fence(__ATOMIC_ACQUIRE, "agent");
            asm volatile("s_waitcnt vmcnt(0)" ::: "memory");
        }
    }
    __syncthreads();
}

typedef GAS unsigned gu32;
struct Args { const float* in[32]; float* out; unsigned char* ws; int ph_lo, ph_hi, li, pad; };
enum { IN_X = 0, IN_P, IN_POS, IN_F1N, IN_F1G, IN_F1U, IN_F1D, IN_MIXN, IN_WIN, IN_MU, IN_W0, IN_W2, IN_A0, IN_A2, IN_G2, IN_KK, IN_KA, IN_RK, IN_GNW, IN_GNB,
       IN_QN, IN_KN, IN_BRR, IN_BRA, IN_WOUT, IN_F2N, IN_F2G, IN_F2U, IN_F2D, IN_PLEN, IN_PLEG, IN_PLEP };
constexpr int N_PHASES = 11;
#ifndef EN0
#define EN0 1
#endif
#ifndef EN1
#define EN1 1
#endif
#ifndef EN2
#define EN2 1
#endif
#ifndef EN3
#define EN3 1
#endif
#ifndef EN4
#define EN4 1
#endif
#ifndef EN5
#define EN5 1
#endif
#ifndef EN6
#define EN6 1
#endif
#ifndef EN10
#define EN10 1
#endif

__device__ __forceinline__ float wave_sum(float v) {
#pragma unroll
    for (int o = 1; o < 64; o <<= 1) v += __shfl_xor(v, o);
    return v;
}
__device__ __forceinline__ float row16_sum(float v) {
    v += __builtin_bit_cast(float, __builtin_amdgcn_update_dpp(0, __builtin_bit_cast(int, v), 0xB1, 0xF, 0xF, true));
    v += __builtin_bit_cast(float, __builtin_amdgcn_update_dpp(0, __builtin_bit_cast(int, v), 0x4E, 0xF, 0xF, true));
    v += __builtin_bit_cast(float, __builtin_amdgcn_update_dpp(0, __builtin_bit_cast(int, v), 0x141, 0xF, 0xF, true));
    v += __builtin_bit_cast(float, __builtin_amdgcn_update_dpp(0, __builtin_bit_cast(int, v), 0x140, 0xF, 0xF, true));
    return v;
}

__device__ __forceinline__ void transpose_item(const float* W, int ldw, int c0, const float* gain, int k0, bf16_t* WT, int ldt, int drow0, LAS float* scr, int lane) {
#pragma unroll 8
    for (int i = 0; i < 32; ++i) { const int kk = 2 * i + (lane >> 5); float v = W[(size_t)(k0 + kk) * ldw + c0 + (lane & 31)]; if (gain) v *= gain[k0 + kk]; scr[kk * 33 + (lane & 31)] = v; }
    asm volatile("s_waitcnt lgkmcnt(0)" ::: "memory");
    const int c = lane & 7;
#pragma unroll
    for (int j = 0; j < 4; ++j) { const int n = (lane >> 3) + 8 * j; const LAS float* s = scr + (8 * c) * 33 + n;
        u32x4 o; o[0] = pk2(s[0 * 33], s[1 * 33]); o[1] = pk2(s[2 * 33], s[3 * 33]); o[2] = pk2(s[4 * 33], s[5 * 33]); o[3] = pk2(s[6 * 33], s[7 * 33]);
        *(u32x4*)(WT + (size_t)(drow0 + n) * ldt + k0 + 8 * c) = o; }
    asm volatile("s_waitcnt lgkmcnt(0)" ::: "memory");
}
enum { MAP_PLAIN = 0, MAP_CAT = 1, MAP_WIN = 2 };
__device__ __forceinline__ void conv_item(const float* W, const float* W2, const float* gain, int ldw, int K, int ndst, int map, bf16_t* WT, int item, LAS float* scr, int lane) {
    const int nblk = ndst / 32, kb = item / nblk, nb = item - kb * nblk, R0 = nb * 32;
    const float* src = W; int c0 = R0;
    if (map == MAP_CAT) { const int pn = R0 >> 8, g = (R0 >> 7) & 1, jj = R0 & 127; src = g ? W2 : W; c0 = 128 * pn + jj; }
    else if (map == MAP_WIN) { const int pn = R0 >> 8; if (pn >= 7 && pn < 16) { const int ct = R0 & 255, bj = ct >> 7, wc = (ct >> 5) & 3; c0 = 256 * pn + 64 * wc + 32 * bj; } }
    transpose_item(src, ldw, c0, gain, kb * 64, WT, K, R0, scr, lane);
}
struct ConvSel { const float* W; const float* W2; const float* gain; bf16_t* WT; int ldw, K, ndst, map, item; bool found; };
#define CJ(W_, W2_, G_, LDW_, K_, ND_, MAP_, WT_) { const int n_ = ((K_) / 64) * ((ND_) / 32); if (!s.found && r < n_) { s.W = (W_); s.W2 = (W2_); s.gain = (G_); s.ldw = (LDW_); s.K = (K_); s.ndst = (ND_); s.map = (MAP_); s.WT = (WT_); s.item = r; s.found = true; } r -= n_; }
constexpr int CONV_EARLY_ITEMS = 2816 + 1408 + 3072 + 256 + 128 + 512 + 16 + 16 + 32;
constexpr int CONV_LATE_ITEMS = 2816 + 1408 + 512 + 128;

__device__ __forceinline__ void row_to_bf16_ssq(const float* xrow, bf16_t* orow, float* ssqrow, int lane) {
    const f32x4* xr = (const f32x4*)xrow + lane;
    f32x4 v[4]; float s = 0.f;
#pragma unroll
    for (int j = 0; j < 4; ++j) { v[j] = xr[64 * j]; s += (v[j][0] * v[j][0] + v[j][1] * v[j][1]) + (v[j][2] * v[j][2] + v[j][3] * v[j][3]); }
    s = wave_sum(s);
    u32x2* o8 = (u32x2*)orow + lane;
#pragma unroll
    for (int j = 0; j < 4; ++j) { u32x2 w; w[0] = pk2(v[j][0], v[j][1]); w[1] = pk2(v[j][2], v[j][3]); o8[64 * j] = w; }
    if (lane < 4) { f32x4 z = {lane == 0 ? s : 0.f, 0.f, 0.f, 0.f}; *((f32x4*)ssqrow + lane) = z; }
}

constexpr int CH = 32;
constexpr int SBW = 392;
constexpr int L_SB = 0, L_LW = CH * SBW * 4, L_LA = L_LW + CH * 64 * 4, L_LG = L_LA + CH * 64 * 4, L_Y = L_LG + CH * 64 * 4, L_RW_END = L_Y + CH * 64 * 4;
static_assert(L_RW_END <= RING_BYTES, "rwkv LDS");

__device__ __forceinline__ float lerp_shift(float cur, float prev, float mu) { return cur + (prev - cur) * mu; }
__device__ __forceinline__ void unpack8(const u32x4 q, float (&f)[8]) { f[0] = bflo(q[0]); f[1] = bfhi(q[0]); f[2] = bflo(q[1]); f[3] = bfhi(q[1]); f[4] = bflo(q[2]); f[5] = bfhi(q[2]); f[6] = bflo(q[3]); f[7] = bfhi(q[3]); }
__device__ __forceinline__ bf16x8 pack8(const float (&f)[8]) { u32x4 w; w[0] = pk2(f[0], f[1]); w[1] = pk2(f[2], f[3]); w[2] = pk2(f[4], f[5]); w[3] = pk2(f[6], f[7]); return __builtin_bit_cast(bf16x8, w); }

__device__ __forceinline__ void rwkv_unit(const Args& A, int b, int h, LAS unsigned char* lds) {
    const int tid = threadIdx.x, lane = tid & 63, w = __builtin_amdgcn_readfirstlane(tid >> 6);
    const bf16_t* zr = (const bf16_t*)(A.ws + WS_D);
    bf16_t* ycat = (bf16_t*)(A.ws + WS_XB);
    const bf16_t* w2t = (const bf16_t*)(A.ws + WS_LORA); const bf16_t* a2t = w2t + 512 * 64; const bf16_t* g2t = a2t + 512 * 64;
    const float* mu = A.in[IN_MU];
    LAS float* SB = (LAS float*)(lds + L_SB); LAS float* LW = (LAS float*)(lds + L_LW); LAS float* LA = (LAS float*)(lds + L_LA); LAS float* LG = (LAS float*)(lds + L_LG); LAS float* Y = (LAS float*)(lds + L_Y);
    const int tt = w >> 2, ct = w & 3, lr = lane & 15, lq = lane >> 4;
    bf16x8 bw[2], ba[2], bg[4];
    { const int n = 64 * h + 16 * ct + lr;
#pragma unroll
      for (int ks = 0; ks < 2; ++ks) { bw[ks] = *(const bf16x8*)(w2t + (size_t)n * 64 + 32 * ks + 8 * lq); ba[ks] = *(const bf16x8*)(a2t + (size_t)n * 64 + 32 * ks + 8 * lq); }
#pragma unroll
      for (int ks = 0; ks < 4; ++ks) bg[ks] = *(const bf16x8*)(g2t + (size_t)n * 128 + 32 * ks + 8 * lq); }
    const int tok = tid >> 4, cg = tid & 15, c4 = 4 * cg, hc = 64 * h + c4;
    const f32x4 mu_r = *(const f32x4*)(mu + hc), mu_k = *(const f32x4*)(mu + 512 + hc), mu_v = *(const f32x4*)(mu + 1024 + hc);
    const f32x4 w0v = *(const f32x4*)(A.in[IN_W0] + hc), a0v = *(const f32x4*)(A.in[IN_A0] + hc), kkv = *(const f32x4*)(A.in[IN_KK] + hc), kav = *(const f32x4*)(A.in[IN_KA] + hc);
    const f32x4 rkv = *(const f32x4*)(A.in[IN_RK] + hc), gnw = *(const f32x4*)(A.in[IN_GNW] + hc), gnb = *(const f32x4*)(A.in[IN_GNB] + hc);
    const int cc = lane & 15, row0 = 8 * w + 2 * (lane >> 4);
    f32x4 s0 = {0.f, 0.f, 0.f, 0.f}, s1 = {0.f, 0.f, 0.f, 0.f};

    for (int t0 = 0; t0 < SEQ; t0 += CH) {
        {
            const int tl = 16 * tt + lr, tpos = t0 + tl; const size_t tg = (size_t)b * SEQ + tpos;
            const bf16_t* zc = zr + tg * RWC; const bool hasprev = tpos > 0;
            f32x4 accw = {0.f, 0.f, 0.f, 0.f}, acca = accw, accg = accw;
#pragma unroll
            for (int ks = 0; ks < 8; ++ks) {
                const int col = 1536 + 32 * ks + 8 * lq;
                const u32x4 cq = *(const u32x4*)(zc + col); u32x4 pq = {0u, 0u, 0u, 0u}; if (hasprev) pq = *(const u32x4*)(zc - RWC + col);
                float c[8], p[8], x[8]; unpack8(cq, c); unpack8(pq, p);
                const f32x4 m0 = *(const f32x4*)(mu + col), m1 = *(const f32x4*)(mu + col + 4);
#pragma unroll
                for (int j = 0; j < 8; ++j) { const float xv = lerp_shift(c[j], p[j], j < 4 ? m0[j] : m1[j - 4]);
                    x[j] = ks < 2 ? (1.0f - 2.0f * __builtin_amdgcn_rcpf(1.0f + __builtin_amdgcn_exp2f(xv * 2.8853900817779268f))) : (ks < 4 ? xv : fast_sigmoid(xv)); }
                const bf16x8 af = pack8(x);
                if (ks < 2) accw = __builtin_amdgcn_mfma_f32_16x16x32_bf16(af, bw[ks], accw, 0, 0, 0);
                else if (ks < 4) acca = __builtin_amdgcn_mfma_f32_16x16x32_bf16(af, ba[ks - 2], acca, 0, 0, 0);
                else accg = __builtin_amdgcn_mfma_f32_16x16x32_bf16(af, bg[ks - 4], accg, 0, 0, 0);
            }
#pragma unroll
            for (int r = 0; r < 4; ++r) { const int o = (16 * tt + 4 * lq + r) * 64 + 16 * ct + lr; LW[o] = accw[r]; LA[o] = acca[r]; LG[o] = accg[r]; }
        }
        __syncthreads();
        f32x4 vv, gg; float rkb;
        {
            const int tpos = t0 + tok; const size_t tg = (size_t)b * SEQ + tpos; const bf16_t* zc = zr + tg * RWC; const bool hasprev = tpos > 0;
            f32x4 r4, k4;
            {
                const u32x2 cr = *(const u32x2*)(zc + hc), ck = *(const u32x2*)(zc + 512 + hc), cv = *(const u32x2*)(zc + 1024 + hc);
                u32x2 pr = {0u, 0u}, pk = pr, pv = pr;
                if (hasprev) { pr = *(const u32x2*)(zc - RWC + hc); pk = *(const u32x2*)(zc - RWC + 512 + hc); pv = *(const u32x2*)(zc - RWC + 1024 + hc); }
                r4[0] = lerp_shift(bflo(cr[0]), bflo(pr[0]), mu_r[0]); r4[1] = lerp_shift(bfhi(cr[0]), bfhi(pr[0]), mu_r[1]); r4[2] = lerp_shift(bflo(cr[1]), bflo(pr[1]), mu_r[2]); r4[3] = lerp_shift(bfhi(cr[1]), bfhi(pr[1]), mu_r[3]);
                k4[0] = lerp_shift(bflo(ck[0]), bflo(pk[0]), mu_k[0]); k4[1] = lerp_shift(bfhi(ck[0]), bfhi(pk[0]), mu_k[1]); k4[2] = lerp_shift(bflo(ck[1]), bflo(pk[1]), mu_k[2]); k4[3] = lerp_shift(bfhi(ck[1]), bfhi(pk[1]), mu_k[3]);
                vv[0] = lerp_shift(bflo(cv[0]), bflo(pv[0]), mu_v[0]); vv[1] = lerp_shift(bfhi(cv[0]), bfhi(pv[0]), mu_v[1]); vv[2] = lerp_shift(bflo(cv[1]), bflo(pv[1]), mu_v[2]); vv[3] = lerp_shift(bfhi(cv[1]), bfhi(pv[1]), mu_v[3]);
            }
            const f32x4 wpre = *(const LAS f32x4*)(LW + tok * 64 + c4), apre = *(const LAS f32x4*)(LA + tok * 64 + c4); gg = *(const LAS f32x4*)(LG + tok * 64 + c4);
            f32x4 dec, av, kkn, km;
            float ssk = 0.f;
#pragma unroll
            for (int j = 0; j < 4; ++j) {
                const float xw = -(w0v[j] + wpre[j]);
                const float sp = fmaxf(xw, 0.f) + __logf(1.0f + __expf(-fabsf(xw)));
                const float wl = -sp - 0.5f;
                dec[j] = __expf(-__expf(wl));
                av[j] = 1.0f / (1.0f + __expf(-(a0v[j] + apre[j])));
                kkn[j] = k4[j] * kkv[j]; ssk += kkn[j] * kkn[j];
                km[j] = k4[j] * (1.0f + (av[j] - 1.0f) * kav[j]);
            }
            ssk = row16_sum(ssk);
            const float kinv = 1.0f / sqrtf(fmaxf(ssk, 1e-24f));
            f32x4 nkk, kka, wr; float c1 = 0.f, c2 = 0.f, rk = 0.f;
#pragma unroll
            for (int j = 0; j < 4; ++j) { const float kn = kkn[j] * kinv; nkk[j] = -kn; kka[j] = kn * av[j]; wr[j] = dec[j] * r4[j]; c1 += kka[j] * r4[j]; c2 += km[j] * r4[j]; rk += r4[j] * km[j] * rkv[j]; }
            c1 = row16_sum(c1); c2 = row16_sum(c2); rkb = row16_sum(rk);
            LAS float* sb = SB + tok * SBW;
            *(LAS f32x4*)(sb + c4) = dec; *(LAS f32x4*)(sb + 64 + c4) = nkk; *(LAS f32x4*)(sb + 128 + c4) = kka; *(LAS f32x4*)(sb + 192 + c4) = km; *(LAS f32x4*)(sb + 256 + c4) = wr; *(LAS f32x4*)(sb + 320 + c4) = vv;
            if (cg == 0) { f32x2 cc2 = {c1, c2}; *(LAS f32x2*)(sb + 384) = cc2; }
        }
        __syncthreads();
#pragma unroll 2
        for (int i = 0; i < CH; ++i) {
            const LAS float* sb = SB + i * SBW;
            const f32x4 dec = *(const LAS f32x4*)(sb + 4 * cc), nkk = *(const LAS f32x4*)(sb + 64 + 4 * cc), kka = *(const LAS f32x4*)(sb + 128 + 4 * cc), km = *(const LAS f32x4*)(sb + 192 + 4 * cc), wr = *(const LAS f32x4*)(sb + 256 + 4 * cc);
            const f32x2 v2 = *(const LAS f32x2*)(sb + 320 + row0), c12 = *(const LAS f32x2*)(sb + 384);
            float sa0 = (s0[0] * nkk[0] + s0[1] * nkk[1]) + (s0[2] * nkk[2] + s0[3] * nkk[3]);
            float sa1 = (s1[0] * nkk[0] + s1[1] * nkk[1]) + (s1[2] * nkk[2] + s1[3] * nkk[3]);
            float u0 = (s0[0] * wr[0] + s0[1] * wr[1]) + (s0[2] * wr[2] + s0[3] * wr[3]);
            float u1 = (s1[0] * wr[0] + s1[1] * wr[1]) + (s1[2] * wr[2] + s1[3] * wr[3]);
            sa0 = row16_sum(sa0); sa1 = row16_sum(sa1); u0 = row16_sum(u0); u1 = row16_sum(u1);
            s0 = s0 * dec + (kka * sa0 + km * v2[0]);
            s1 = s1 * dec + (kka * sa1 + km * v2[1]);
            if (cc == 0) { f32x2 y2 = {u0 + sa0 * c12[0] + v2[0] * c12[1], u1 + sa1 * c12[0] + v2[1] * c12[1]}; *(LAS f32x2*)(Y + i * 64 + row0) = y2; }
        }
        __syncthreads();
        {
            const f32x4 y4 = *(const LAS f32x4*)(Y + tok * 64 + c4);
            const float mean = row16_sum((y4[0] + y4[1]) + (y4[2] + y4[3])) * (1.0f / 64.0f);
            const f32x4 d = y4 - mean;
            const float var = row16_sum((d[0] * d[0] + d[1] * d[1]) + (d[2] * d[2] + d[3] * d[3])) * (1.0f / 64.0f);
            const float rstd = 1.0f / sqrtf(var + GN_EPS);
            const f32x4 o = ((d * rstd) * gnw + gnb + vv * rkb) * gg;
            u32x2 wq; wq[0] = pk2(o[0], o[1]); wq[1] = pk2(o[2], o[3]);
            *(u32x2*)(ycat + ((size_t)b * SEQ + t0 + tok) * YC + hc) = wq;
        }
    }
}

typedef short v4i16_t __attribute__((ext_vector_type(4)));
__device__ __forceinline__ int crow(int r, int hi) { return (r & 3) + 8 * (r >> 2) + 4 * hi; }
__device__ __forceinline__ void attn_item(bf16_t* Qa, const bf16_t* Ka, const bf16_t* Va, float* Lout, int it, float negbound, LAS unsigned char* vl, int lane) {
    const int bh = it >> 6, tile = it & 63, hh = bh % NAH, g = hh >> 2, Lg = SEQ >> (2 * g);
    const int f0 = tile * 32, l0 = f0 & (Lg - 1);
    const size_t base = (size_t)bh * SEQ * HD;
    const int r = lane & 31, h = lane >> 5;
    bf16_t* Qb = Qa + base + (size_t)f0 * HD;
    bf16x8 qf[4];
#pragma unroll
    for (int ks = 0; ks < 4; ++ks) qf[ks] = *(const bf16x8*)(Qb + r * HD + 16 * ks + 8 * h);
    f32x16 o0, o1; float lsum = 0.f;
#pragma unroll
    for (int i = 0; i < 16; ++i) { o0[i] = 0.f; o1[i] = 0.f; }
    const int jstart = l0 >= 128 ? 0 : (128 - l0) >> 5;
    const int g4 = lane >> 4, i16 = lane & 15;
    const int traddr = (4 * (g4 >> 1) + (i16 >> 2)) * 128 + (16 * (g4 & 1) + 4 * (i16 & 3)) * 2;
    for (int j = jstart; j < 5; ++j) {
        const int kf0 = f0 - 128 + 32 * j;
        const bf16_t* Kb = Ka + base + (size_t)kf0 * HD; const bf16_t* Vb = Va + base + (size_t)kf0 * HD;
        u32x4 vst[4];
#pragma unroll
        for (int i = 0; i < 4; ++i) vst[i] = *(const u32x4*)(Vb + ((lane >> 3) + 8 * i) * HD + (lane & 7) * 8);
        f32x16 s;
#pragma unroll
        for (int i = 0; i < 16; ++i) s[i] = negbound;
#pragma unroll
        for (int ks = 0; ks < 4; ++ks) { const bf16x8 kfr = *(const bf16x8*)(Kb + r * HD + 16 * ks + 8 * h); s = __builtin_amdgcn_mfma_f32_32x32x16_bf16(kfr, qf[ks], s, 0, 0, 0); }
#pragma unroll
        for (int i = 0; i < 4; ++i) *(LAS u32x4*)(vl + ((lane >> 3) + 8 * i) * 128 + (lane & 7) * 16) = vst[i];
        float p[16];
#pragma unroll
        for (int i = 0; i < 16; ++i) { const int kk = crow(i, h); const bool valid = (j == 0 ? kk >= r : true) && (j == 4 ? kk <= r : true); p[i] = valid ? __builtin_amdgcn_exp2f(s[i]) : 0.f; lsum += p[i]; }
        bf16x8 pa[2];
#pragma unroll
        for (int sx = 0; sx < 2; ++sx) { u32x4 wq; wq[0] = pk2(p[8 * sx + 0], p[8 * sx + 1]); wq[1] = pk2(p[8 * sx + 2], p[8 * sx + 3]); wq[2] = pk2(p[8 * sx + 4], p[8 * sx + 5]); wq[3] = pk2(p[8 * sx + 6], p[8 * sx + 7]); pa[sx] = __builtin_bit_cast(bf16x8, wq); }
#pragma unroll
        for (int mt = 0; mt < 2; ++mt)
#pragma unroll
            for (int sx = 0; sx < 2; ++sx) {
                const LAS unsigned char* ap = vl + traddr + sx * 16 * 128 + mt * 64;
                const v4i16_t lo = __builtin_amdgcn_ds_read_tr16_b64_v4i16((LAS v4i16_t*)ap), hi = __builtin_amdgcn_ds_read_tr16_b64_v4i16((LAS v4i16_t*)(ap + 8 * 128));
                const bf16x8 vf = {lo[0], lo[1], lo[2], lo[3], hi[0], hi[1], hi[2], hi[3]};
                if (mt == 0) o0 = __builtin_amdgcn_mfma_f32_32x32x16_bf16(vf, pa[sx], o0, 0, 0, 0); else o1 = __builtin_amdgcn_mfma_f32_32x32x16_bf16(vf, pa[sx], o1, 0, 0, 0);
            }
    }
    lsum += __shfl_xor(lsum, 32);
    if (h == 0) Lout[(size_t)bh * SEQ + f0 + r] = lsum;
#pragma unroll
    for (int q4 = 0; q4 < 4; ++q4) {
        u32x2 w0, w1; w0[0] = pk2(o0[4 * q4], o0[4 * q4 + 1]); w0[1] = pk2(o0[4 * q4 + 2], o0[4 * q4 + 3]); w1[0] = pk2(o1[4 * q4], o1[4 * q4 + 1]); w1[1] = pk2(o1[4 * q4 + 2], o1[4 * q4 + 3]);
        *(u32x2*)(Qb + r * HD + 8 * q4 + 4 * h) = w0; *(u32x2*)(Qb + r * HD + 32 + 8 * q4 + 4 * h) = w1;
    }
}

struct Ctx { LAS unsigned char* lds; unsigned char* ws; int tid, lane, wave, G, bx, gw, NGW; };

__device__ __forceinline__ void phase_prologue(const Args& args, const Ctx& c) {
    unsigned char* ws = c.ws;
    LAS float* scr = (LAS float*)(c.lds + c.wave * 16384);
    for (int it = c.gw; it < CONV_EARLY_ITEMS; it += c.NGW) {
        ConvSel s; s.found = false; s.W = nullptr; s.W2 = nullptr; s.gain = nullptr; s.WT = nullptr; s.ldw = 0; s.K = 64; s.ndst = 32; s.map = 0; s.item = 0; int r = it;
        CJ(args.in[IN_F1G], args.in[IN_F1U], args.in[IN_F1N], FF, DM, 2 * FF, MAP_CAT, (bf16_t*)(ws + WS_W1CAT))
        CJ(args.in[IN_F1D], nullptr, nullptr, DM, FF, DM, MAP_PLAIN, (bf16_t*)(ws + WS_W1D))
        CJ(args.in[IN_WIN], nullptr, args.in[IN_MIXN], NIN, DM, NIN, MAP_WIN, (bf16_t*)(ws + WS_WIN))
        CJ(args.in[IN_BRR], nullptr, nullptr, DM, RWD, DM, MAP_PLAIN, (bf16_t*)(ws + WS_WBRA))
        CJ(args.in[IN_BRA], nullptr, nullptr, DM, 256, DM, MAP_PLAIN, (bf16_t*)(ws + WS_WBRB))
        CJ(args.in[IN_WOUT], nullptr, nullptr, DM, DM, DM, MAP_PLAIN, (bf16_t*)(ws + WS_WOUT))
        CJ(args.in[IN_W2], nullptr, nullptr, RWD, 64, RWD, MAP_PLAIN, (bf16_t*)(ws + WS_LORA))
        CJ(args.in[IN_A2], nullptr, nullptr, RWD, 64, RWD, MAP_PLAIN, (bf16_t*)(ws + WS_LORA) + 512 * 64)
        CJ(args.in[IN_G2], nullptr, nullptr, RWD, 128, RWD, MAP_PLAIN, (bf16_t*)(ws + WS_LORA) + 2 * 512 * 64)
        conv_item(s.W, s.W2, s.gain, s.ldw, s.K, s.ndst, s.map, s.WT, s.item, scr, c.lane);
    }
    bf16_t* xb = (bf16_t*)(ws + WS_XB); float* ssq = (float*)(ws + WS_SSQ);
    for (int m = c.gw; m < T; m += c.NGW) row_to_bf16_ssq(args.in[IN_X] + (size_t)m * DM, xb + (size_t)m * DM, ssq + (size_t)m * 16, c.lane);
    const int* pos = (const int*)args.in[IN_POS];
    float* cosT = (float*)(ws + WS_COS); float* sinT = (float*)(ws + WS_SIN);
    for (int e = c.bx * 512 + c.tid; e < T * 32; e += c.G * 512) {
        const int t = e >> 5, i = e & 31;
        const double inv = exp2(-(double)i * (13.287712379549449 / 32.0));
        const double ang = (double)pos[t] * inv;
        cosT[e] = (float)cos(ang); sinT[e] = (float)sin(ang);
    }
}
__device__ __forceinline__ void phase_swiglu(const Ctx& c, size_t ws_w) {
    pg8::Gemm g{(const bf16_t*)(c.ws + WS_XB), (const bf16_t*)(c.ws + ws_w), DM, DM, T, 2 * FF, DM};
    pg8::StaticOrder S; S.init(T, 2 * FF, c.G, c.bx);
    pg8::EpiSwiglu E{(bf16_t*)(c.ws + WS_C), (const float*)(c.ws + WS_SSQ)};
    pg8::gemm_phase<pg8::EpiSwiglu, pg8::StaticOrder, true, true>(c.lds, g, S, E);
}
__device__ __forceinline__ void phase_resid(const Ctx& c, const bf16_t* A, int K, size_t ws_w, const float* xold, float* xnew, float coef) {
    pg8::Gemm g{A, (const bf16_t*)(c.ws + ws_w), K, K, T, DM, K};
    pg8::StaticOrder S; S.init(T, DM, c.G, c.bx);
    pg8::EpiResid E{xold, xnew, (bf16_t*)(c.ws + WS_XB), (float*)(c.ws + WS_SSQ), coef};
    pg8::gemm_phase<pg8::EpiResid, pg8::StaticOrder, false, true>(c.lds, g, S, E);
}
__device__ __forceinline__ void phase_win(const Args& args, const Ctx& c) {
    pg8::Gemm g{(const bf16_t*)(c.ws + WS_XB), (const bf16_t*)(c.ws + WS_WIN), DM, DM, T, NIN, DM};
    pg8::StaticOrder S; S.init(T, NIN, c.G, c.bx);
    pg8::EpiWin E{(const float*)(c.ws + WS_SSQ), (bf16_t*)(c.ws + WS_D), (bf16_t*)(c.ws + WS_C), (bf16_t*)(c.ws + WS_GATE), (const float*)(c.ws + WS_COS), (const float*)(c.ws + WS_SIN), args.in[IN_QN], args.in[IN_KN]};
    pg8::gemm_phase<pg8::EpiWin, pg8::StaticOrder, true, true>(c.lds, g, S, E);
}
__device__ __forceinline__ void phase_mixers(const Args& args, const Ctx& c) {
    if (c.bx < 64) rwkv_unit(args, c.bx >> 3, c.bx & 7, c.lds);
    else {
        bf16_t* qkv = (bf16_t*)(c.ws + WS_C);
        float gq = fabsf(args.in[IN_QN][c.lane]), gk = fabsf(args.in[IN_KN][c.lane]);
#pragma unroll
        for (int o = 1; o < 64; o <<= 1) { gq = fmaxf(gq, __shfl_xor(gq, o)); gk = fmaxf(gk, __shfl_xor(gk, o)); }
        const float negbound = -(8.0f * 1.4426950408889634f) * gq * gk;
        const int nw = (c.G - 64) * NWAVES;
        for (int it = (c.bx - 64) * NWAVES + c.wave; it < NB * NAH * 64; it += nw)
            attn_item(qkv, qkv + QKV_SEC, qkv + 2 * QKV_SEC, (float*)(c.ws + WS_ATL), it, negbound, c.lds + c.wave * 4096, c.lane);
    }
}
__device__ __forceinline__ void phase_combine_late(const Args& args, const Ctx& c) {
    unsigned char* ws = c.ws;
    const bf16_t* qkv = (const bf16_t*)(ws + WS_C); const float* atl = (const float*)(ws + WS_ATL); bf16_t* ycat = (bf16_t*)(ws + WS_XB);
    for (int e = c.bx * 512 + c.tid; e < T * 32; e += c.G * 512) {
        const int t = e >> 5, j = (e >> 3) & 3, c8 = e & 7, b = t >> 11, s = t & 2047;
        float num[8] = {0.f, 0.f, 0.f, 0.f, 0.f, 0.f, 0.f, 0.f}; float den = 0.f;
#pragma unroll
        for (int g = 0; g < 3; ++g) {
            const int sh = 2 * g, idx = ((s & ((1 << sh) - 1)) << (11 - sh)) + (s >> sh);
            const size_t off = (size_t)(b * NAH + 4 * g + j) * SEQ + idx;
            const u32x4 q = *(const u32x4*)(qkv + off * HD + 8 * c8); float f[8]; unpack8(q, f);
#pragma unroll
            for (int i = 0; i < 8; ++i) num[i] += f[i];
            den += atl[off];
        }
        const float inv = 1.0f / den;
        u32x4 wq; wq[0] = pk2(num[0] * inv, num[1] * inv); wq[1] = pk2(num[2] * inv, num[3] * inv); wq[2] = pk2(num[4] * inv, num[5] * inv); wq[3] = pk2(num[6] * inv, num[7] * inv);
        *(u32x4*)(ycat + (size_t)t * YC + 512 + 64 * j + 8 * c8) = wq;
    }
    LAS float* scr = (LAS float*)(c.lds + c.wave * 16384);
    for (int it = c.gw; it < CONV_LATE_ITEMS; it += c.NGW) {
        ConvSel s; s.found = false; s.W = nullptr; s.W2 = nullptr; s.gain = nullptr; s.WT = nullptr; s.ldw = 0; s.K = 64; s.ndst = 32; s.map = 0; s.item = 0; int r = it;
        CJ(args.in[IN_F2G], args.in[IN_F2U], args.in[IN_F2N], FF, DM, 2 * FF, MAP_CAT, (bf16_t*)(ws + WS_W2CAT))
        CJ(args.in[IN_F2D], nullptr, nullptr, DM, FF, DM, MAP_PLAIN, (bf16_t*)(ws + WS_W2D))
        CJ(args.in[IN_PLEG], nullptr, args.in[IN_PLEN], DM, DM, DM, MAP_PLAIN, (bf16_t*)(ws + WS_WPG))
        CJ(args.in[IN_PLEP], nullptr, nullptr, DM, PLE, DM, MAP_PLAIN, (bf16_t*)(ws + WS_WPP))
        conv_item(s.W, s.W2, s.gain, s.ldw, s.K, s.ndst, s.map, s.WT, s.item, scr, c.lane);
    }
    bf16_t* pb = (bf16_t*)(ws + WS_PB);
    for (int e = c.bx * 512 + c.tid; e < T * PLE / 8; e += c.G * 512) {
        const f32x4 a = *(const f32x4*)(args.in[IN_P] + (size_t)e * 8), d = *(const f32x4*)(args.in[IN_P] + (size_t)e * 8 + 4);
        u32x4 wq; wq[0] = pk2(a[0], a[1]); wq[1] = pk2(a[2], a[3]); wq[2] = pk2(d[0], d[1]); wq[3] = pk2(d[2], d[3]);
        *(u32x4*)(pb + (size_t)e * 8) = wq;
    }
}
__device__ __forceinline__ void phase_gate_gemm(const Ctx& c, const bf16_t* A, int lda, int K, size_t ws_w, bf16_t* O, const bf16_t* gate, int goff, const bf16_t* addp) {
    pg8::Gemm g{A, (const bf16_t*)(c.ws + ws_w), lda, K, T, DM, K};
    pg8::StaticOrder S; S.init(T, DM, c.G, c.bx);
    pg8::EpiGateBf16 E{O, gate, goff, addp};
    pg8::gemm_phase<pg8::EpiGateBf16, pg8::StaticOrder, false, true>(c.lds, g, S, E);
    asm volatile("s_waitcnt vmcnt(0)" ::: "memory"); __syncthreads();
}
__device__ __forceinline__ void phase_ple(const Args& args, const Ctx& c) {
    pg8::Gemm g{(const bf16_t*)(c.ws + WS_XB), (const bf16_t*)(c.ws + WS_WPG), DM, DM, T, DM, DM};
    pg8::StaticOrder S; S.init(T, DM, c.G, c.bx);
    pg8::EpiPle E{args.out, args.out, (const float*)(c.ws + WS_SSQ), (const bf16_t*)(c.ws + WS_C)};
    pg8::gemm_phase<pg8::EpiPle, pg8::StaticOrder, false, true>(c.lds, g, S, E);
}

__global__ void __launch_bounds__(NWAVES * 64, 2) mk_fwd(Args args) {
    extern __shared__ __attribute__((aligned(16))) unsigned char lds_raw[];
    Ctx c;
    c.lds = (LAS unsigned char*)lds_raw; c.ws = args.ws;
    c.tid = threadIdx.x; c.lane = c.tid & 63; c.wave = __builtin_amdgcn_readfirstlane(c.tid >> 6);
    c.G = gridDim.x; c.bx = blockIdx.x; c.gw = c.bx * NWAVES + c.wave; c.NGW = c.G * NWAVES;
    volatile LAS unsigned* MISC = (volatile LAS unsigned*)(c.lds + MISC_OFF);
    for (int u = c.tid; u < (LDS_BYTES - RING_BYTES) / 4; u += NWAVES * 64) ((LAS unsigned*)(c.lds + RING_BYTES))[u] = 0u;
    __syncthreads();
#if MK_ONE_LAUNCH
    XcdBarrier bar = xcd_barrier_post((unsigned*)(c.ws + WS_CTL) + 4096, MISC + 8);
#define GRID_BAR() xcd_barrier(bar)
#else
    (void)MISC;
#define GRID_BAR() do {} while (0)
#endif
    const int lo = args.ph_lo, hi = args.ph_hi;
#define IN(k) (lo <= (k) && (k) < hi)
#define SEAM(k) do { if (IN(k) && IN((k) + 1)) GRID_BAR(); } while (0)
    unsigned char* ws = c.ws;
    bf16_t* hU = (bf16_t*)(ws + WS_C); bf16_t* merged = (bf16_t*)(ws + WS_C); bf16_t* m1 = (bf16_t*)(ws + WS_C + 32 * MiB); bf16_t* pp = (bf16_t*)(ws + WS_C);
    bf16_t* ycat = (bf16_t*)(ws + WS_XB); const bf16_t* gates = (const bf16_t*)(ws + WS_GATE);

    if (EN0 && IN(0)) phase_prologue(args, c);
    SEAM(0);
    if (EN1 && IN(1)) phase_swiglu(c, WS_W1CAT);
    SEAM(1);
    if (EN2 && IN(2)) phase_resid(c, hU, FF, WS_W1D, args.in[IN_X], args.out, 0.5f);
    SEAM(2);
    if (EN3 && IN(3)) phase_win(args, c);
    SEAM(3);
    if (EN4 && IN(4)) phase_mixers(args, c);
    SEAM(4);
    if (EN5 && IN(5)) phase_combine_late(args, c);
    SEAM(5);
    if (EN6 && IN(6)) {
        phase_gate_gemm(c, ycat, YC, RWD, WS_WBRA, m1, gates, 0, nullptr);
        phase_gate_gemm(c, ycat + 512, YC, 256, WS_WBRB, merged, gates, DM, m1);
    }
    SEAM(6);
    if (EN2 && IN(7)) phase_resid(c, merged, DM, WS_WOUT, args.out, args.out, 1.0f);
    SEAM(7);
    if (EN1 && IN(8)) phase_swiglu(c, WS_W2CAT);
    SEAM(8);
    if (EN2 && IN(9)) phase_resid(c, hU, FF, WS_W2D, args.out, args.out, 0.5f);
    SEAM(9);
    if (EN10 && IN(10)) {
        phase_gate_gemm(c, (const bf16_t*)(ws + WS_PB), PLE, PLE, WS_WPP, pp, nullptr, 0, nullptr);
        phase_ple(args, c);
    }
}

extern "C" void kernel_launch(void* const* d_in, const int* in_sizes, int n_in, void* d_out, int out_size, void* d_ws, size_t ws_size, hipStream_t stream) {
    static int grid = 0;
    if (grid == 0) {
        if (n_in != 32 || in_sizes[0] != T * DM || out_size != T * DM || ws_size < WS_END) { fprintf(stderr, "kernel_launch: unexpected problem shape (n_in %d, in0 %d, out %d, ws %zu); nothing launched\n", n_in, n_in > 0 ? in_sizes[0] : -1, out_size, ws_size); grid = -1; return; }
        int dev = 0, cus = 0, per_cu = 0;
        if (hipGetDevice(&dev) != hipSuccess || hipDeviceGetAttribute(&cus, hipDeviceAttributeMultiprocessorCount, dev) != hipSuccess) { grid = -1; return; }
        if (hipFuncSetAttribute((const void*)mk_fwd, hipFuncAttributeMaxDynamicSharedMemorySize, LDS_BYTES) != hipSuccess) { fprintf(stderr, "kernel_launch: hipFuncSetAttribute failed\n"); grid = -1; return; }
        if (hipOccupancyMaxActiveBlocksPerMultiprocessor(&per_cu, (const void*)mk_fwd, NWAVES * 64, LDS_BYTES) != hipSuccess || per_cu < 1) { fprintf(stderr, "kernel_launch: occupancy query reports %d workgroups per CU\n", per_cu); }
        (void)hipGetLastError();
        grid = cus;
        if (grid != 256) fprintf(stderr, "kernel_launch: %d CUs; this kernel is built for a 256-CU device\n", grid);
    }
    if (grid < 0) return;
    (void)hipMemsetAsync((char*)d_ws + WS_CTL, 0, CTL_ZERO_BYTES, stream);
    Args a{};
    for (int i = 0; i < 32; ++i) a.in[i] = (const float*)d_in[i];
    a.out = (float*)d_out; a.ws = (unsigned char*)d_ws;
#if MK_ONE_LAUNCH
    a.ph_lo = 0; a.ph_hi = N_PHASES; a.li = 0;
    hipLaunchKernelGGL(mk_fwd, dim3(grid), dim3(NWAVES * 64), LDS_BYTES, stream, a);
#else
    for (int ph = 0; ph < N_PHASES; ++ph) {
        a.ph_lo = ph; a.ph_hi = ph + 1; a.li = ph;
        hipLaunchKernelGGL(mk_fwd, dim3(grid), dim3(NWAVES * 64), LDS_BYTES, stream, a);
    }
#endif
    const hipError_t le = hipPeekAtLastError();
    if (le != hipSuccess) fprintf(stderr, "kernel_launch: launch failed: %s\n", hipGetErrorName(le));
}
```

```cpp
#include <hip/hip_runtime.h>
#include <cstdio>
#include <cstdint>

#ifndef MK_ONE_LAUNCH
#define MK_ONE_LAUNCH 1
#endif

#define LAS __attribute__((address_space(3)))
#define GAS __attribute__((address_space(1)))
typedef unsigned short bf16_t;
typedef short bf16x8 __attribute__((ext_vector_type(8)));
typedef short s16x4 __attribute__((ext_vector_type(4)));
typedef float f32x4 __attribute__((ext_vector_type(4)));
typedef float f32x2 __attribute__((ext_vector_type(2)));
typedef float f32x16 __attribute__((ext_vector_type(16)));
typedef unsigned u32x4 __attribute__((ext_vector_type(4)));
typedef unsigned u32x2 __attribute__((ext_vector_type(2)));
typedef __bf16 bf16x2_t __attribute__((ext_vector_type(2)));

__device__ __forceinline__ unsigned pk2(float lo, float hi) { f32x2 v = {lo, hi}; bf16x2_t b = __builtin_convertvector(v, bf16x2_t); return __builtin_bit_cast(unsigned, b); }
__device__ __forceinline__ float bflo(unsigned w) { return __uint_as_float(w << 16); }
__device__ __forceinline__ float bfhi(unsigned w) { return __uint_as_float(w & 0xffff0000u); }
__device__ __forceinline__ float fast_exp(float x) { return __builtin_amdgcn_exp2f(x * 1.4426950408889634f); }
__device__ __forceinline__ float fast_sigmoid(float x) { return __builtin_amdgcn_rcpf(1.0f + __builtin_amdgcn_exp2f(-x * 1.4426950408889634f)); }

constexpr int NB = 8, SEQ = 2048, T = NB * SEQ, DM = 1024, FF = 2816, NIN = 6144, PLE = 256;
constexpr int RWD = 512, RWC = 1792, NAH = 12, HD = 64, YC = 768;
constexpr float RMS_EPS = 1e-6f, GN_EPS = 64e-5f;
constexpr float QSCALE = 0.125f * 1.4426950408889634f;

constexpr size_t MiB = 1u << 20;
constexpr size_t WS_CTL = 0, CTL_ZERO_BYTES = 64 * 1024;
constexpr size_t WS_SSQ = 1 * MiB;
constexpr size_t WS_LORA = 2 * MiB;
constexpr size_t WS_ATL = 2 * MiB + 256 * 1024;
constexpr size_t WS_C = 4 * MiB;
constexpr size_t WS_M1 = 36 * MiB;
constexpr size_t WS_GATE = 76 * MiB;
constexpr size_t WS_W1CAT = 92 * MiB, WS_W1D = 103 * MiB;
constexpr size_t WS_D = 140 * MiB;
constexpr size_t WS_W2CAT = WS_D, WS_W2D = WS_D + 11 * MiB, WS_WPG = WS_D + 17 * MiB, WS_WPP = WS_D + 19 * MiB;
constexpr size_t WS_WBRA = WS_D + 20 * MiB, WS_WBRB = WS_D + 21 * MiB, WS_WOUT = WS_D + 22 * MiB, WS_PB = WS_D + 24 * MiB;
constexpr size_t WS_XB = 196 * MiB;
constexpr size_t WS_BUFA = 220 * MiB, WS_BUFB = 236 * MiB;
constexpr size_t WS_WIN = 228 * MiB;
constexpr size_t WS_COS = 240 * MiB, WS_SIN = 242 * MiB;
constexpr size_t WS_COMP = 252 * MiB;
constexpr size_t WS_END = 256 * MiB;
constexpr size_t QKV_SEC = (size_t)NB * NAH * SEQ * HD;

constexpr int RING_BYTES = 131072, LDS_BYTES = 163840, MISC_OFF = LDS_BYTES - 256;
constexpr int NWAVES = 8;
namespace pg8 {
#define PG8_LAS __attribute__((address_space(3)))
constexpr int BM = 256, BK = 64, HALF = 128, HTB = HALF * BK * 2  , STAGE_BYTES = 8 * HTB, NXCD = 8, WGM = 8;

__host__ __device__ __forceinline__ int lds_byte(int r, int c) { const int st = (r >> 4) * 2 + (c >> 5), rr = r & 15, cc = c & 31, ob = rr * 64 + cc * 2; return st * 1024 + (ob ^ (((ob >> 9) & 1) << 5)); }
__host__ __device__ __forceinline__ void stage_rc(int b, int& R, int& C) { const int st = b / 1024, sb = b % 1024, swz = sb ^ (((sb >> 9) & 1) << 5); R = (st >> 1) * 16 + swz / 64; C = (st & 1) * 32 + (swz % 64) / 2; }
__host__ __device__ __forceinline__ int perm32(int rho) { const int n = rho >> 4, i = rho & 15; return 8 * (i >> 2) + 4 * n + (i & 3); }

struct Unit { int pm, pn; };
struct Gemm { const bf16_t* A; const bf16_t* Bt; int lda, ldb, M, N, K; };

struct StaticOrder {
    int nM, nN, nwg, G, c;
    __host__ __device__ void init(int M, int N, int G_, int c_) { nM = M / BM; nN = N / BM; nwg = nM * nN; G = G_; c = c_; }
    __host__ __device__ bool next(int i, Unit& u) const {
        const long L = (long)i * G + c; if (L >= nwg) return false;
        int wgid = (int)L; { const int q = nwg / NXCD, r = nwg % NXCD, xcd = wgid % NXCD, off = wgid / NXCD; wgid = (xcd < r ? xcd * (q + 1) : r * (q + 1) + (xcd - r) * q) + off; }
        const int nig = WGM * nN, gid = wgid / nig, fm = gid * WGM, gsz = (nM - fm) < WGM ? (nM - fm) : WGM;
        u.pm = fm + ((wgid % nig) % gsz); u.pn = (wgid % nig) / gsz; return true;
    }
    __device__ __forceinline__ void a_ready(const Unit&) const {}
    __device__ __forceinline__ void done(const Unit&) const {}
};


typedef f32x4 Acc[2][2][4][2];

__device__ __forceinline__ float load_rs1(const float* ssq, int row, int fq) {
    const f32x4 v = *(const f32x4*)(ssq + (size_t)row * 16 + 4 * fq);
    float s = (v[0] + v[1]) + (v[2] + v[3]);
    s += __shfl_xor(s, 16); s += __shfl_xor(s, 32);
    return 1.0f / sqrtf(s * (1.0f / DM) + RMS_EPS);
}
__device__ __forceinline__ float silu_mul(float g, float u) { return g * fast_sigmoid(g) * u; }

struct EpiSwiglu {
    static constexpr bool PERM = true, AFTER_DRAIN = false;
    bf16_t* H; const float* ssq;
    __device__ __forceinline__ void operator()(const Acc& acc, const Unit& u, int wr, int wc, int fr, int fq) const {
        const int row0 = u.pm * BM + wr * 64 + fr, col0 = u.pn * HALF + wc * 32 + 8 * fq;
#pragma unroll
        for (int ai = 0; ai < 2; ++ai)
#pragma unroll
            for (int m = 0; m < 4; ++m) {
                const float r = load_rs1(ssq, row0 + ai * HALF + m * 16, fq);
                const f32x4 g0 = acc[ai][0][m][0] * r, g1 = acc[ai][0][m][1] * r, u0 = acc[ai][1][m][0] * r, u1 = acc[ai][1][m][1] * r;
                u32x4 w;
                w[0] = pk2(silu_mul(g0[0], u0[0]), silu_mul(g0[1], u0[1])); w[1] = pk2(silu_mul(g0[2], u0[2]), silu_mul(g0[3], u0[3]));
                w[2] = pk2(silu_mul(g1[0], u1[0]), silu_mul(g1[1], u1[1])); w[3] = pk2(silu_mul(g1[2], u1[2]), silu_mul(g1[3], u1[3]));
                *(u32x4*)(H + (size_t)(row0 + ai * HALF + m * 16) * FF + col0) = w;
                if (m & 1) asm volatile("" ::: "memory");
            }
    }
};

struct EpiResid {
    static constexpr bool PERM = false, AFTER_DRAIN = false;
    const float* xold; float* xnew; bf16_t* xb; float* ssq; float coef;
    __device__ __forceinline__ void operator()(const Acc& acc, const Unit& u, int wr, int wc, int fr, int fq) const {
        const int row0 = u.pm * BM + wr * 64 + fr, col0 = u.pn * BM + wc * 32 + 4 * fq;
#pragma unroll
        for (int ai = 0; ai < 2; ++ai)
#pragma unroll
            for (int m = 0; m < 4; ++m) {
                const int row = row0 + ai * HALF + m * 16; const size_t off = (size_t)row * DM + col0; float s = 0.f;
#pragma unroll
                for (int bj = 0; bj < 2; ++bj)
#pragma unroll
                    for (int n = 0; n < 2; ++n) {
                        const size_t o = off + bj * HALF + n * 16;
                        const f32x4 v = *(const f32x4*)(xold + o) + acc[ai][bj][m][n] * coef;
                        *(f32x4*)(xnew + o) = v; s += (v[0] * v[0] + v[1] * v[1]) + (v[2] * v[2] + v[3] * v[3]);
                        u32x2 w; w[0] = pk2(v[0], v[1]); w[1] = pk2(v[2], v[3]); *(u32x2*)(xb + o) = w;
                    }
                s += __shfl_xor(s, 16); s += __shfl_xor(s, 32);
                if (fq == 0) ssq[(size_t)row * 16 + 4 * u.pn + wc] = s;
                if (m & 1) asm volatile("" ::: "memory");
            }
    }
};

struct EpiWin {
    static constexpr bool PERM = true, AFTER_DRAIN = false;
    const float* ssq; bf16_t* zr; bf16_t* qkv; bf16_t* gates; const float* cosT; const float* sinT; const float* qg; const float* kg;
    __device__ __forceinline__ void operator()(const Acc& acc, const Unit& u, int wr, int wc, int fr, int fq) const {
        const int row0 = u.pm * BM + wr * 64 + fr, pn = u.pn;
        if (pn < 7) {
            const int col0 = pn * BM + wc * 32 + 8 * fq;
#pragma unroll
            for (int ai = 0; ai < 2; ++ai)
#pragma unroll
                for (int m = 0; m < 4; ++m) { const float r = load_rs1(ssq, row0 + ai * HALF + m * 16, fq); bf16_t* rowp = zr + (size_t)(row0 + ai * HALF + m * 16) * RWC + col0;
#pragma unroll
                    for (int bj = 0; bj < 2; ++bj) { const f32x4 v0 = acc[ai][bj][m][0] * r, v1 = acc[ai][bj][m][1] * r;
                        u32x4 w; w[0] = pk2(v0[0], v0[1]); w[1] = pk2(v0[2], v0[3]); w[2] = pk2(v1[0], v1[1]); w[3] = pk2(v1[2], v1[3]);
                        *(u32x4*)(rowp + bj * HALF) = w; }
                    if (m & 1) asm volatile("" ::: "memory"); }
        } else if (pn < 16) {
            const int sec = (pn - 7) / 3, g = (pn - 7) - 3 * sec, hh = 4 * g + wc, sh = 2 * g;
            bf16_t* secp = qkv + (size_t)sec * QKV_SEC;
            f32x4 gn[2][2];
            if (sec < 2) { const float* gp = sec == 0 ? qg : kg;
#pragma unroll
                for (int bj = 0; bj < 2; ++bj)
#pragma unroll
                    for (int n = 0; n < 2; ++n) gn[bj][n] = *(const f32x4*)(gp + 32 * bj + 8 * fq + 4 * n); }
            const float osc = sec == 0 ? QSCALE : 1.0f;
#pragma unroll
            for (int ai = 0; ai < 2; ++ai)
#pragma unroll
                for (int m = 0; m < 4; ++m) {
                    const int row = row0 + ai * HALF + m * 16; const float r = load_rs1(ssq, row0 + ai * HALF + m * 16, fq);
                    const int b = row >> 11, s = row & 2047, idx = ((s & ((1 << sh) - 1)) << (11 - sh)) + (s >> sh);
                    bf16_t* dst = secp + ((size_t)(b * NAH + hh) * SEQ + idx) * HD + 8 * fq;
                    f32x4 v[2][2];
#pragma unroll
                    for (int bj = 0; bj < 2; ++bj)
#pragma unroll
                        for (int n = 0; n < 2; ++n) v[bj][n] = acc[ai][bj][m][n] * r;
                    if (sec < 2) {
                        float ss = 0.f;
#pragma unroll
                        for (int bj = 0; bj < 2; ++bj)
#pragma unroll
                            for (int n = 0; n < 2; ++n) ss += (v[bj][n][0] * v[bj][n][0] + v[bj][n][1] * v[bj][n][1]) + (v[bj][n][2] * v[bj][n][2] + v[bj][n][3] * v[bj][n][3]);
                        ss += __shfl_xor(ss, 16); ss += __shfl_xor(ss, 32);
                        const float inv = osc / sqrtf(ss * (1.0f / HD) + RMS_EPS);
#pragma unroll
                        for (int n = 0; n < 2; ++n) {
                            const f32x4 c = *(const f32x4*)(cosT + (size_t)row * 32 + 8 * fq + 4 * n), sn = *(const f32x4*)(sinT + (size_t)row * 32 + 8 * fq + 4 * n);
                            const f32x4 y0 = v[0][n] * gn[0][n] * inv, y1 = v[1][n] * gn[1][n] * inv;
                            v[0][n] = y0 * c - y1 * sn; v[1][n] = y1 * c + y0 * sn;
                        }
                    }
#pragma unroll
                    for (int bj = 0; bj < 2; ++bj) { u32x4 w; w[0] = pk2(v[bj][0][0], v[bj][0][1]); w[1] = pk2(v[bj][0][2], v[bj][0][3]); w[2] = pk2(v[bj][1][0], v[bj][1][1]); w[3] = pk2(v[bj][1][2], v[bj][1][3]);
                        *(u32x4*)(dst + 32 * bj) = w; }
                    asm volatile("" ::: "memory");
                }
        } else {
            const int col0 = (pn - 16) * BM + wc * 32 + 8 * fq;
#pragma unroll
            for (int ai = 0; ai < 2; ++ai)
#pragma unroll
                for (int m = 0; m < 4; ++m) { const float r = load_rs1(ssq, row0 + ai * HALF + m * 16, fq); bf16_t* rowp = gates + (size_t)(row0 + ai * HALF + m * 16) * 2048 + col0;
#pragma unroll
                    for (int bj = 0; bj < 2; ++bj) { const f32x4 v0 = acc[ai][bj][m][0] * r, v1 = acc[ai][bj][m][1] * r;
                        u32x4 w; w[0] = pk2(fast_sigmoid(v0[0]), fast_sigmoid(v0[1])); w[1] = pk2(fast_sigmoid(v0[2]), fast_sigmoid(v0[3]));
                        w[2] = pk2(fast_sigmoid(v1[0]), fast_sigmoid(v1[1])); w[3] = pk2(fast_sigmoid(v1[2]), fast_sigmoid(v1[3]));
                        *(u32x4*)(rowp + bj * HALF) = w; }
                    if (m & 1) asm volatile("" ::: "memory"); }
        }
    }
};

struct EpiGateBf16 {
    static constexpr bool PERM = true, AFTER_DRAIN = false;
    bf16_t* O; const bf16_t* gate; int goff; const bf16_t* addp;
    __device__ __forceinline__ void operator()(const Acc& acc, const Unit& u, int wr, int wc, int fr, int fq) const {
        const int row0 = u.pm * BM + wr * 64 + fr, col0 = u.pn * BM + wc * 32 + 8 * fq;
#pragma unroll
        for (int ai = 0; ai < 2; ++ai)
#pragma unroll
            for (int m = 0; m < 4; ++m) {
                const int row = row0 + ai * HALF + m * 16;
#pragma unroll
                for (int bj = 0; bj < 2; ++bj) {
                    f32x4 v0 = acc[ai][bj][m][0], v1 = acc[ai][bj][m][1];
                    if (gate) { const u32x4 gq = *(const u32x4*)(gate + (size_t)row * 2048 + goff + col0 + bj * HALF);
                        v0[0] *= bflo(gq[0]); v0[1] *= bfhi(gq[0]); v0[2] *= bflo(gq[1]); v0[3] *= bfhi(gq[1]); v1[0] *= bflo(gq[2]); v1[1] *= bfhi(gq[2]); v1[2] *= bflo(gq[3]); v1[3] *= bfhi(gq[3]); }
                    if (addp) { const u32x4 aq = *(const u32x4*)(addp + (size_t)row * DM + col0 + bj * HALF);
                        v0[0] += bflo(aq[0]); v0[1] += bfhi(aq[0]); v0[2] += bflo(aq[1]); v0[3] += bfhi(aq[1]); v1[0] += bflo(aq[2]); v1[1] += bfhi(aq[2]); v1[2] += bflo(aq[3]); v1[3] += bfhi(aq[3]); }
                    u32x4 w; w[0] = pk2(v0[0], v0[1]); w[1] = pk2(v0[2], v0[3]); w[2] = pk2(v1[0], v1[1]); w[3] = pk2(v1[2], v1[3]);
                    *(u32x4*)(O + (size_t)row * DM + col0 + bj * HALF) = w;
                }
                if (m & 1) asm volatile("" ::: "memory");
            }
    }
};

struct EpiPle {
    static constexpr bool PERM = false, AFTER_DRAIN = false;
    const float* xold; float* out; const float* ssq; const bf16_t* pp;
    __device__ __forceinline__ void operator()(const Acc& acc, const Unit& u, int wr, int wc, int fr, int fq) const {
        const int row0 = u.pm * BM + wr * 64 + fr, col0 = u.pn * BM + wc * 32 + 4 * fq;
#pragma unroll
        for (int ai = 0; ai < 2; ++ai)
#pragma unroll
            for (int m = 0; m < 4; ++m) {
                const int row = row0 + ai * HALF + m * 16; const size_t off = (size_t)row * DM + col0; const float r = load_rs1(ssq, row0 + ai * HALF + m * 16, fq);
#pragma unroll
                for (int bj = 0; bj < 2; ++bj)
#pragma unroll
                    for (int n = 0; n < 2; ++n) {
                        const size_t o = off + bj * HALF + n * 16;
                        const u32x2 pq = *(const u32x2*)(pp + o); const f32x4 a = acc[ai][bj][m][n] * r; f32x4 v = *(const f32x4*)(xold + o);
                        v[0] += fast_sigmoid(a[0]) * bflo(pq[0]); v[1] += fast_sigmoid(a[1]) * bfhi(pq[0]); v[2] += fast_sigmoid(a[2]) * bflo(pq[1]); v[3] += fast_sigmoid(a[3]) * bfhi(pq[1]);
                        *(f32x4*)(out + o) = v;
                    }
                if (m & 1) asm volatile("" ::: "memory");
            }
    }
};
template <class Epi, class Sched, bool ALIGN_EPI = false, bool SP2 = false>
__device__ __forceinline__ void gemm_phase(PG8_LAS unsigned char* lds, const Gemm g, const Sched& S, const Epi& E) {
    const int tid = threadIdx.x, wid = __builtin_amdgcn_readfirstlane(tid >> 6), lane = tid & 63, wr = wid >> 2, wc = wid & 3, fr = lane & 15, fq = lane >> 4;
    const int K = g.K, nt = K / BK;
    unsigned voffA[2], voffB[2];
#pragma unroll
    for (int i = 0; i < 2; ++i) { int R, C; stage_rc(tid * 16 + i * 8192, R, C); const int Rb = Epi::PERM ? ((R & ~31) + perm32(R & 31)) : R;
        voffA[i] = (unsigned)(R * g.lda + C) * 2u; voffB[i] = (unsigned)(Rb * g.ldb + C) * 2u; }
    const size_t kstep = (size_t)(BK * 2);
    const size_t hstepA = (size_t)HALF * g.lda * 2, hstepB = (size_t)HALF * g.ldb * 2;
    const size_t tstepA = 2 * hstepA, tstepB = 2 * hstepB;
    const unsigned ldsw = (unsigned)wid * 1024u;
    const int aoff = lds_byte(wr * 64 + fr, fq * 8), boff = lds_byte(wc * 32 + fr, fq * 8);
#define PG8_SA(b, h) (((b) * 2 + (h)) * HTB)
#define PG8_SB(b, h) ((4 + (b) * 2 + (h)) * HTB)
#define PG8_STAGE(bufoff, gbase, voff) do { _Pragma("unroll") for (int _i = 0; _i < 2; ++_i) \
        __builtin_amdgcn_global_load_lds((const unsigned*)((const char*)(gbase) + (voff)[_i]), (PG8_LAS unsigned*)(lds + (bufoff) + ldsw + _i * 8192), 16, 0, 0); } while (0)
#define PG8_LDA(dst, b, h) do { _Pragma("unroll") for (int m = 0; m < 4; ++m) _Pragma("unroll") for (int k = 0; k < 2; ++k) dst[m][k] = *(const PG8_LAS bf16x8*)(lds + PG8_SA(b, h) + aoff + m * 2048 + k * 1024); } while (0)
#define PG8_LDB(dst, b, h) do { _Pragma("unroll") for (int n = 0; n < 2; ++n) _Pragma("unroll") for (int k = 0; k < 2; ++k) dst[n][k] = *(const PG8_LAS bf16x8*)(lds + PG8_SB(b, h) + boff + n * 2048 + k * 1024); } while (0)
#define PG8_MMA(ai, bj, At, Bt) do { __builtin_amdgcn_s_setprio(1); _Pragma("unroll") for (int m = 0; m < 4; ++m) _Pragma("unroll") for (int n = 0; n < 2; ++n) _Pragma("unroll") for (int k = 0; k < 2; ++k) \
        acc[ai][bj][m][n] = __builtin_amdgcn_mfma_f32_16x16x32_bf16(Bt[n][k], At[m][k], acc[ai][bj][m][n], 0, 0, 0); __builtin_amdgcn_s_setprio(0); } while (0)
#define PG8_WAIT_V(n) asm volatile("s_waitcnt vmcnt(" #n ")" ::: "memory")
#define PG8_WAIT_L(n) asm volatile("s_waitcnt lgkmcnt(" #n ")" ::: "memory")
#define PG8_BAR __builtin_amdgcn_s_barrier()
#define PG8_SCHED __builtin_amdgcn_sched_barrier(0)
    Unit cur, nxt; int ui = 0;
    if (!S.next(0, cur)) return;
    f32x4 acc[2][2][4][2];
#pragma unroll
    for (int a = 0; a < 2; ++a)
#pragma unroll
        for (int b = 0; b < 2; ++b)
#pragma unroll
            for (int m = 0; m < 4; ++m)
#pragma unroll
                for (int n = 0; n < 2; ++n) acc[a][b][m][n] = (f32x4){0.f, 0.f, 0.f, 0.f};
    bf16x8 At[4][2], B0[2][2], B1[2][2];
    const char* cA = (const char*)g.A + (size_t)cur.pm * tstepA; const char* cB = (const char*)g.Bt + (size_t)cur.pn * tstepB;
    S.a_ready(cur);
    if constexpr (SP2) {
        PG8_STAGE(PG8_SB(0, 0), cB, voffB); PG8_STAGE(PG8_SB(0, 1), cB + hstepB, voffB); PG8_STAGE(PG8_SA(0, 0), cA, voffA); PG8_STAGE(PG8_SA(0, 1), cA + hstepA, voffA);
        if (wr == 1) PG8_BAR;
        PG8_WAIT_V(2); PG8_BAR;
        PG8_STAGE(PG8_SB(1, 0), cB + kstep, voffB); PG8_STAGE(PG8_SA(1, 0), cA + kstep, voffA); PG8_STAGE(PG8_SB(1, 1), cB + hstepB + kstep, voffB);
        PG8_WAIT_V(6); PG8_BAR;
    } else {
        PG8_STAGE(PG8_SB(0, 0), cB, voffB); PG8_STAGE(PG8_SA(0, 0), cA, voffA); PG8_STAGE(PG8_SB(0, 1), cB + hstepB, voffB); PG8_STAGE(PG8_SA(0, 1), cA + hstepA, voffA);
        if (wr == 1) PG8_BAR;
        PG8_WAIT_V(4); PG8_BAR;
        PG8_STAGE(PG8_SB(1, 0), cB + kstep, voffB); PG8_STAGE(PG8_SA(1, 0), cA + kstep, voffA); PG8_STAGE(PG8_SB(1, 1), cB + hstepB + kstep, voffB);
        PG8_WAIT_V(6); PG8_BAR;
    }
    for (;;) {
        const bool has_next = S.next(ui + 1, nxt);
        const char* nA = has_next ? (const char*)g.A + (size_t)nxt.pm * tstepA : cA; const char* nB = has_next ? (const char*)g.Bt + (size_t)nxt.pn * tstepB : cB;
        for (int t = 0; t < nt; t += 2) {
            const bool last = (t == nt - 2);
            const char* a1 = cA + (size_t)(t + 1) * kstep;
            const char* a2 = last ? nA : cA + (size_t)(t + 2) * kstep; const char* b2 = last ? nB : cB + (size_t)(t + 2) * kstep;
            const char* a3 = a2 + kstep; const char* b3 = b2 + kstep;
            if (last && has_next) S.a_ready(nxt);
            if constexpr (SP2) {
            PG8_LDB(B0, 0, 0); PG8_LDB(B1, 0, 1); PG8_SCHED; PG8_LDA(At, 0, 0); PG8_STAGE(PG8_SA(1, 1), a1 + hstepA, voffA);
            PG8_WAIT_V(8); PG8_WAIT_L(0); PG8_BAR; PG8_MMA(0, 0, At, B0); PG8_MMA(0, 1, At, B1); PG8_BAR; PG8_SCHED;
            PG8_LDA(At, 0, 1); PG8_STAGE(PG8_SB(0, 0), b2, voffB); PG8_STAGE(PG8_SB(0, 1), b2 + hstepB, voffB); PG8_STAGE(PG8_SA(0, 0), a2, voffA);
            PG8_WAIT_V(8); PG8_WAIT_L(0); PG8_BAR; PG8_MMA(1, 0, At, B0); PG8_MMA(1, 1, At, B1); PG8_BAR; PG8_SCHED;
            PG8_LDB(B0, 1, 0); PG8_LDB(B1, 1, 1); PG8_SCHED; PG8_LDA(At, 1, 0); PG8_STAGE(PG8_SA(0, 1), a2 + hstepA, voffA);
            PG8_WAIT_V(8); PG8_WAIT_L(0); PG8_BAR; PG8_MMA(0, 0, At, B0); PG8_MMA(0, 1, At, B1); PG8_BAR; PG8_SCHED;
            PG8_LDA(At, 1, 1); PG8_STAGE(PG8_SB(1, 0), b3, voffB); PG8_STAGE(PG8_SB(1, 1), b3 + hstepB, voffB); PG8_STAGE(PG8_SA(1, 0), a3, voffA);
            PG8_WAIT_V(8); PG8_WAIT_L(0); PG8_BAR; PG8_MMA(1, 0, At, B0); PG8_MMA(1, 1, At, B1); PG8_BAR; PG8_SCHED;
            } else {
            PG8_LDB(B0, 0, 0); PG8_SCHED; PG8_LDA(At, 0, 0); PG8_STAGE(PG8_SA(1, 1), a1 + hstepA, voffA);
            PG8_WAIT_L(8); PG8_BAR; PG8_WAIT_L(0); PG8_MMA(0, 0, At, B0); PG8_BAR; PG8_SCHED;
            PG8_LDB(B1, 0, 1); PG8_STAGE(PG8_SB(0, 0), b2, voffB);
            PG8_BAR; PG8_WAIT_L(0); PG8_MMA(0, 1, At, B1); PG8_BAR;
            PG8_LDA(At, 0, 1); PG8_STAGE(PG8_SA(0, 0), a2, voffA);
            PG8_BAR; PG8_WAIT_L(0); PG8_MMA(1, 0, At, B0); PG8_BAR; PG8_SCHED;
            PG8_STAGE(PG8_SB(0, 1), b2 + hstepB, voffB);
            PG8_WAIT_V(6); PG8_BAR; PG8_MMA(1, 1, At, B1); PG8_BAR;
            PG8_LDB(B0, 1, 0); PG8_SCHED; PG8_LDA(At, 1, 0); PG8_STAGE(PG8_SA(0, 1), a2 + hstepA, voffA);
            PG8_WAIT_L(8); PG8_BAR; PG8_WAIT_L(0); PG8_MMA(0, 0, At, B0); PG8_BAR; PG8_SCHED;
            PG8_LDB(B1, 1, 1); PG8_STAGE(PG8_SB(1, 0), b3, voffB);
            PG8_BAR; PG8_WAIT_L(0); PG8_MMA(0, 1, At, B1); PG8_BAR;
            PG8_LDA(At, 1, 1); PG8_STAGE(PG8_SA(1, 0), a3, voffA);
            PG8_BAR; PG8_WAIT_L(0); PG8_MMA(1, 0, At, B0); PG8_BAR; PG8_SCHED;
            PG8_STAGE(PG8_SB(1, 1), b3 + hstepB, voffB);
            PG8_WAIT_V(6); PG8_BAR; PG8_MMA(1, 1, At, B1); PG8_BAR;
            }
        }
        if constexpr (ALIGN_EPI) { if (wr == 0) PG8_BAR; }
        if constexpr (!Epi::AFTER_DRAIN) { E(acc, cur, wr, wc, fr, fq); S.done(cur); }
        if (!has_next) break;
#pragma unroll
        for (int a = 0; a < 2; ++a)
#pragma unroll
            for (int b = 0; b < 2; ++b)
#pragma unroll
                for (int m = 0; m < 4; ++m)
#pragma unroll
                    for (int n = 0; n < 2; ++n) acc[a][b][m][n] = (f32x4){0.f, 0.f, 0.f, 0.f};
        cur = nxt; cA = nA; cB = nB; ++ui;
        if constexpr (ALIGN_EPI) { if (wr == 1) PG8_BAR; }
    }
    PG8_WAIT_V(0);
    if constexpr (!ALIGN_EPI) { if (wr == 0) PG8_BAR; }
    PG8_BAR;
    if constexpr (Epi::AFTER_DRAIN) { E.fused(acc, cur, wr, wc, fr, fq, lds, wid, lane); S.done(cur); }
#undef PG8_SA
#undef PG8_SB
#undef PG8_STAGE
#undef PG8_LDA
#undef PG8_LDB
#undef PG8_MMA
#undef PG8_WAIT_V
#undef PG8_WAIT_L
#undef PG8_BAR
#undef PG8_SCHED
}
}

#define XB_TMO      128
#define XB_XCNT(j)  (256  + 64 * (j))
#define XB_XSUB(j)  (1280 + 64 * (j))
#define XB_XGEN(j)  (2304 + 64 * (j))
#define XB_TOP      3328
#define XB_TOPGEN   3392
#define XCD_BAR_WORDS 3456
#define XB_SPIN_CAP (1u << 18)

__device__ __forceinline__ unsigned xb_ld(unsigned* p)              { return __hip_atomic_load(p, __ATOMIC_RELAXED, __HIP_MEMORY_SCOPE_AGENT); }
__device__ __forceinline__ unsigned xb_add(unsigned* p, unsigned v) { return __hip_atomic_fetch_add(p, v, __ATOMIC_RELAXED, __HIP_MEMORY_SCOPE_AGENT); }
__device__ __forceinline__ unsigned xb_xcc_id() { return (unsigned)__builtin_amdgcn_s_getreg((3 << 11) | 20) & 0xFu; }
#define XB_SPIN(cond, bar) do { unsigned _sp = 0; while (cond) { __builtin_amdgcn_s_sleep(1); \
    if ((++_sp & 255u) == 0u) { if (xb_ld(&(bar)[XB_TMO])) break; if (_sp > XB_SPIN_CAP) { atomicAdd(&(bar)[XB_TMO], 1u); break; } } } } while (0)

struct XcdBarrier {
    unsigned* bar; unsigned x;
    volatile LAS unsigned* st;
};

__device__ __forceinline__ XcdBarrier xcd_barrier_post(unsigned* bar, volatile LAS unsigned* st) {
    XcdBarrier b; b.bar = bar; b.x = xb_xcc_id(); b.st = st;
    if (threadIdx.x == 0) (void)xb_add(&bar[XB_XCNT(b.x)], 1u);
    return b;
}
__device__ __forceinline__ void xcd_barrier_complete(unsigned* bar, unsigned x, unsigned& nloc, unsigned& nx) {
    const unsigned G = gridDim.x * gridDim.y * gridDim.z;
    unsigned sum, cnt, mine, sp = 0u;
    for (;;) {
        sum = 0u; cnt = 0u; mine = 0u;
#pragma unroll
        for (unsigned j = 0; j < 16; ++j) { const unsigned c = xb_ld(&bar[XB_XCNT(j)]); sum += c; cnt += (c > 0u) ? 1u : 0u; mine = (j == x) ? c : mine; }
        if (sum == G) break;
        __builtin_amdgcn_s_sleep(1);
        if ((++sp & 255u) == 0u) { if (xb_ld(&bar[XB_TMO])) break; if (sp > XB_SPIN_CAP) { atomicAdd(&bar[XB_TMO], 1u); break; } }
    }
    nloc = mine > 0u ? mine : 1u; nx = cnt > 0u ? cnt : 1u;
}

__device__ __forceinline__ void xcd_barrier(const XcdBarrier& b) {
    asm volatile("s_waitcnt vmcnt(0)" ::: "memory");
    __syncthreads();
    if (threadIdx.x == 0) {
        unsigned* bar = b.bar;
        __builtin_amdgcn_s_waitcnt(0);
        unsigned nloc = b.st[0], nx = b.st[1];
        if (nloc == 0u) { xcd_barrier_complete(bar, b.x, nloc, nx); b.st[0] = nloc; b.st[1] = nx; }
        const unsigned old = xb_add(&bar[XB_XSUB(b.x)], 1u);
        const unsigned gen = old / nloc;
        if (old + 1u == (gen + 1u) * nloc) {
            __builtin_amdgcn_fence(__ATOMIC_RELEASE, "agent");
            asm volatile("s_waitcnt vmcnt(0)" ::: "memory");
            const unsigned og = xb_add(&bar[XB_TOP], 1u);
            const unsigned tg = og / nx;
            if (og + 1u == (tg + 1u) * nx) xb_add(&bar[XB_TOPGEN], 1u);
            else XB_SPIN(xb_ld(&bar[XB_TOPGEN]) == tg, bar);
            __builtin_amdgcn_fence(__ATOMIC_ACQUIRE, "agent");
            xb_add(&bar[XB_XGEN(b.x)], 1u);
            asm volatile("s_waitcnt vmcnt(0)" ::: "memory");
        } else {
            XB_SPIN(xb_ld(&bar[XB_XGEN(b.x)]) == gen, bar);
            __builtin_amdgcn_fence(__ATOMIC_ACQUIRE, "agent");
            asm volatile("s_waitcnt vmcnt(0)" ::: "memory");
        }
    }
    __syncthreads();
}

typedef GAS unsigned gu32;
struct Args { const float* in[32]; float* out; unsigned char* ws; int ph_lo, ph_hi, li, pad; };
enum { IN_X = 0, IN_P, IN_POS, IN_F1N, IN_F1G, IN_F1U, IN_F1D, IN_MIXN, IN_WIN, IN_MU, IN_W0, IN_W2, IN_A0, IN_A2, IN_G2, IN_KK, IN_KA, IN_RK, IN_GNW, IN_GNB,
       IN_QN, IN_KN, IN_BRR, IN_BRA, IN_WOUT, IN_F2N, IN_F2G, IN_F2U, IN_F2D, IN_PLEN, IN_PLEG, IN_PLEP };
constexpr int N_PHASES = 11;
#ifndef ALIGN_MULTI
#define ALIGN_MULTI true
#endif
#ifndef EN0
#define EN0 1
#endif
#ifndef EN1
#define EN1 1
#endif
#ifndef EN2
#define EN2 1
#endif
#ifndef EN3
#define EN3 1
#endif
#ifndef EN4
#define EN4 1
#endif
#ifndef EN5
#define EN5 1
#endif
#ifndef EN6
#define EN6 1
#endif
#ifndef EN10
#define EN10 1
#endif

__device__ __forceinline__ float wave_sum(float v) {
#pragma unroll
    for (int o = 1; o < 64; o <<= 1) v += __shfl_xor(v, o);
    return v;
}
__device__ __forceinline__ float row16_sum(float v) {
    v += __builtin_bit_cast(float, __builtin_amdgcn_update_dpp(0, __builtin_bit_cast(int, v), 0xB1, 0xF, 0xF, true));
    v += __builtin_bit_cast(float, __builtin_amdgcn_update_dpp(0, __builtin_bit_cast(int, v), 0x4E, 0xF, 0xF, true));
    v += __builtin_bit_cast(float, __builtin_amdgcn_update_dpp(0, __builtin_bit_cast(int, v), 0x141, 0xF, 0xF, true));
    v += __builtin_bit_cast(float, __builtin_amdgcn_update_dpp(0, __builtin_bit_cast(int, v), 0x140, 0xF, 0xF, true));
    return v;
}

__device__ __forceinline__ void transpose_item(const float* W, int ldw, int c0, const float* gain, int k0, bf16_t* WT, int ldt, int drow0, LAS float* scr, int lane) {
#pragma unroll 8
    for (int i = 0; i < 32; ++i) { const int kk = 2 * i + (lane >> 5); float v = W[(size_t)(k0 + kk) * ldw + c0 + (lane & 31)]; if (gain) v *= gain[k0 + kk]; scr[kk * 33 + (lane & 31)] = v; }
    asm volatile("s_waitcnt lgkmcnt(0)" ::: "memory");
    const int c = lane & 7;
#pragma unroll
    for (int j = 0; j < 4; ++j) { const int n = (lane >> 3) + 8 * j; const LAS float* s = scr + (8 * c) * 33 + n;
        u32x4 o; o[0] = pk2(s[0 * 33], s[1 * 33]); o[1] = pk2(s[2 * 33], s[3 * 33]); o[2] = pk2(s[4 * 33], s[5 * 33]); o[3] = pk2(s[6 * 33], s[7 * 33]);
        *(u32x4*)(WT + (size_t)(drow0 + n) * ldt + k0 + 8 * c) = o; }
    asm volatile("s_waitcnt lgkmcnt(0)" ::: "memory");
}
enum { MAP_PLAIN = 0, MAP_CAT = 1, MAP_WIN = 2 };
__device__ __forceinline__ void conv_item(const float* W, const float* W2, const float* gain, int ldw, int K, int ndst, int map, bf16_t* WT, int item, LAS float* scr, int lane) {
    const int nblk = ndst / 32, kb = item / nblk, nb = item - kb * nblk, R0 = nb * 32;
    const float* src = W; int c0 = R0;
    if (map == MAP_CAT) { const int pn = R0 >> 8, g = (R0 >> 7) & 1, jj = R0 & 127; src = g ? W2 : W; c0 = 128 * pn + jj; }
    else if (map == MAP_WIN) { const int pn = R0 >> 8; if (pn >= 7 && pn < 16) { const int ct = R0 & 255, bj = ct >> 7, wc = (ct >> 5) & 3; c0 = 256 * pn + 64 * wc + 32 * bj; } }
    transpose_item(src, ldw, c0, gain, kb * 64, WT, K, R0, scr, lane);
}
struct ConvSel { const float* W; const float* W2; const float* gain; bf16_t* WT; int ldw, K, ndst, map, item; bool found; };
#define CJ(W_, W2_, G_, LDW_, K_, ND_, MAP_, WT_) { const int n_ = ((K_) / 64) * ((ND_) / 32); if (!s.found && r < n_) { s.W = (W_); s.W2 = (W2_); s.gain = (G_); s.ldw = (LDW_); s.K = (K_); s.ndst = (ND_); s.map = (MAP_); s.WT = (WT_); s.item = r; s.found = true; } r -= n_; }
constexpr int CONV_EARLY_ITEMS = 2816 + 16 + 16 + 32;
constexpr int CONV_P1_ITEMS = 1408 + 3072;
constexpr int CONV_P8_ITEMS = 1408 + 512 + 128;
constexpr int CONV_LATE_ITEMS = 2816 + 256 + 128 + 512;

__device__ __forceinline__ void row_to_bf16_ssq(const float* xrow, bf16_t* orow, float* ssqrow, int lane) {
    const f32x4* xr = (const f32x4*)xrow + lane;
    f32x4 v[4]; float s = 0.f;
#pragma unroll
    for (int j = 0; j < 4; ++j) { v[j] = xr[64 * j]; s += (v[j][0] * v[j][0] + v[j][1] * v[j][1]) + (v[j][2] * v[j][2] + v[j][3] * v[j][3]); }
    s = wave_sum(s);
    u32x2* o8 = (u32x2*)orow + lane;
#pragma unroll
    for (int j = 0; j < 4; ++j) { u32x2 w; w[0] = pk2(v[j][0], v[j][1]); w[1] = pk2(v[j][2], v[j][3]); o8[64 * j] = w; }
    if (lane < 4) { f32x4 z = {lane == 0 ? s : 0.f, 0.f, 0.f, 0.f}; *((f32x4*)ssqrow + lane) = z; }
}

constexpr int CH = 32;
constexpr int SBW = 392;
constexpr int L_SB = 0, L_LP = CH * SBW * 4, L_LGP = L_LP + 4 * CH * 64 * 4, L_Y = L_LGP + 4 * CH * 16 * 4, L_RW_END = L_Y + CH * 16 * 4;
static_assert(L_RW_END <= RING_BYTES, "rwkv LDS");

__device__ __forceinline__ float lerp_shift(float cur, float prev, float mu) { return cur + (prev - cur) * mu; }
__device__ __forceinline__ void unpack8(const u32x4 q, float (&f)[8]) { f[0] = bflo(q[0]); f[1] = bfhi(q[0]); f[2] = bflo(q[1]); f[3] = bfhi(q[1]); f[4] = bflo(q[2]); f[5] = bfhi(q[2]); f[6] = bflo(q[3]); f[7] = bfhi(q[3]); }
__device__ __forceinline__ bf16x8 pack8(const float (&f)[8]) { u32x4 w; w[0] = pk2(f[0], f[1]); w[1] = pk2(f[2], f[3]); w[2] = pk2(f[4], f[5]); w[3] = pk2(f[6], f[7]); return __builtin_bit_cast(bf16x8, w); }
__device__ __forceinline__ float row32_sum(float v) {
    v = row16_sum(v);
    const unsigned u = __builtin_bit_cast(unsigned, v);
    auto rr = __builtin_amdgcn_permlane16_swap(u, u, false, false);
    return __builtin_bit_cast(float, (unsigned)rr[0]) + __builtin_bit_cast(float, (unsigned)rr[1]);
}
struct RwLoads { u32x4 ac, ap, gc, gp; u32x2 cr, ck, cv, pr, pk, pv; };

__device__ __forceinline__ void rwkv_unit(const Args& A, unsigned char* ws, int b, int h, int q, LAS unsigned char* lds) {
    const int tid = threadIdx.x, lane = tid & 63, w = __builtin_amdgcn_readfirstlane(tid >> 6);
    const bf16_t* zr = (const bf16_t*)(ws + WS_D);
    bf16_t* ycat = (bf16_t*)(ws + WS_XB); bf16_t* bufA = (bf16_t*)(ws + WS_BUFA); bf16_t* bufB = (bf16_t*)(ws + WS_BUFB);
    const bf16_t* w2t = (const bf16_t*)(ws + WS_LORA); const bf16_t* a2t = w2t + 512 * 64; const bf16_t* g2t = a2t + 512 * 64;
    const float* mu = A.in[IN_MU];
    LAS float* SB = (LAS float*)(lds + L_SB); LAS float* LP = (LAS float*)(lds + L_LP); LAS float* LGP = (LAS float*)(lds + L_LGP); LAS float* Y = (LAS float*)(lds + L_Y);
    const int tt = w >> 2, ct = w & 3, lr = lane & 15, lq = lane >> 4;
    bf16x8 bwa[4], bg;
    { const bf16_t* wt = ct < 2 ? w2t : a2t; const int ks = ct & 1;
#pragma unroll
      for (int c4 = 0; c4 < 4; ++c4) bwa[c4] = *(const bf16x8*)(wt + (size_t)(64 * h + 16 * c4 + lr) * 64 + 32 * ks + 8 * lq);
      bg = *(const bf16x8*)(g2t + (size_t)(64 * h + 16 * q + lr) * 128 + 32 * ct + 8 * lq); }
    const int colA = 1536 + 32 * ct + 8 * lq, colG = 1664 + 32 * ct + 8 * lq;
    const f32x4 muA0 = *(const f32x4*)(mu + colA), muA1 = *(const f32x4*)(mu + colA + 4), muG0 = *(const f32x4*)(mu + colG), muG1 = *(const f32x4*)(mu + colG + 4);
    const int tok = tid >> 4, cg = tid & 15, c4 = 4 * cg, hc = 64 * h + c4;
    const bool own = (cg >> 2) == q;
    const f32x4 mu_r = *(const f32x4*)(mu + hc), mu_k = *(const f32x4*)(mu + 512 + hc), mu_v = *(const f32x4*)(mu + 1024 + hc);
    const f32x4 w0v = *(const f32x4*)(A.in[IN_W0] + hc), a0v = *(const f32x4*)(A.in[IN_A0] + hc), kkv = *(const f32x4*)(A.in[IN_KK] + hc), kav = *(const f32x4*)(A.in[IN_KA] + hc);
    const f32x4 rkv = *(const f32x4*)(A.in[IN_RK] + hc), gnw = *(const f32x4*)(A.in[IN_GNW] + hc), gnb = *(const f32x4*)(A.in[IN_GNB] + hc);
    const int l32 = lane & 31, rl = 2 * w + (lane >> 5);
    float s0 = 0.f, s1 = 0.f;
    const size_t tb = (size_t)b * SEQ;

    RwLoads L;
#define RW_LOAD(t0_) do { \
        { const int tpos = (t0_) + 16 * tt + lr; const bf16_t* zc = zr + (tb + tpos) * RWC; const bool hp = tpos > 0; \
          L.ac = *(const u32x4*)(zc + colA); L.gc = *(const u32x4*)(zc + colG); \
          if (hp) { L.ap = *(const u32x4*)(zc - RWC + colA); L.gp = *(const u32x4*)(zc - RWC + colG); } else { L.ap = (u32x4){0u, 0u, 0u, 0u}; L.gp = L.ap; } } \
        { const int tpos = (t0_) + tok; const bf16_t* zc = zr + (tb + tpos) * RWC; const bool hp = tpos > 0; \
          L.cr = *(const u32x2*)(zc + hc); L.ck = *(const u32x2*)(zc + 512 + hc); L.cv = *(const u32x2*)(zc + 1024 + hc); \
          if (hp) { L.pr = *(const u32x2*)(zc - RWC + hc); L.pk = *(const u32x2*)(zc - RWC + 512 + hc); L.pv = *(const u32x2*)(zc - RWC + 1024 + hc); } \
          else { L.pr = (u32x2){0u, 0u}; L.pk = L.pr; L.pv = L.pr; } } } while (0)
    RW_LOAD(0);
#ifndef RW_REP_AB
#define RW_REP_AB 1
#endif
#ifndef RW_REP_C
#define RW_REP_C 1
#endif
    for (int t0 = 0; t0 < SEQ; t0 += CH) {
      for (int repab = 0; repab < RW_REP_AB; ++repab) {
        {
            float c[8], p[8], x[8];
            unpack8(L.ac, c); unpack8(L.ap, p);
#pragma unroll
            for (int j = 0; j < 8; ++j) { const float xv = lerp_shift(c[j], p[j], j < 4 ? muA0[j] : muA1[j - 4]);
                x[j] = ct < 2 ? (1.0f - 2.0f * __builtin_amdgcn_rcpf(1.0f + __builtin_amdgcn_exp2f(xv * 2.8853900817779268f))) : xv; }
            const bf16x8 af = pack8(x);
            unpack8(L.gc, c); unpack8(L.gp, p);
#pragma unroll
            for (int j = 0; j < 8; ++j) x[j] = fast_sigmoid(lerp_shift(c[j], p[j], j < 4 ? muG0[j] : muG1[j - 4]));
            const bf16x8 gf = pack8(x);
            const f32x4 z4 = {0.f, 0.f, 0.f, 0.f};
#pragma unroll
            for (int c16 = 0; c16 < 4; ++c16) {
                const f32x4 acc = __builtin_amdgcn_mfma_f32_16x16x32_bf16(af, bwa[c16], z4, 0, 0, 0);
#pragma unroll
                for (int r = 0; r < 4; ++r) LP[(ct * CH + 16 * tt + 4 * lq + r) * 64 + 16 * c16 + lr] = acc[r];
            }
            const f32x4 accg = __builtin_amdgcn_mfma_f32_16x16x32_bf16(gf, bg, z4, 0, 0, 0);
#pragma unroll
            for (int r = 0; r < 4; ++r) LGP[(ct * CH + 16 * tt + 4 * lq + r) * 16 + lr] = accg[r];
        }
        __syncthreads();
        {
            const size_t tg = tb + t0 + tok;
            f32x4 r4, k4, vv;
            r4[0] = lerp_shift(bflo(L.cr[0]), bflo(L.pr[0]), mu_r[0]); r4[1] = lerp_shift(bfhi(L.cr[0]), bfhi(L.pr[0]), mu_r[1]); r4[2] = lerp_shift(bflo(L.cr[1]), bflo(L.pr[1]), mu_r[2]); r4[3] = lerp_shift(bfhi(L.cr[1]), bfhi(L.pr[1]), mu_r[3]);
            k4[0] = lerp_shift(bflo(L.ck[0]), bflo(L.pk[0]), mu_k[0]); k4[1] = lerp_shift(bfhi(L.ck[0]), bfhi(L.pk[0]), mu_k[1]); k4[2] = lerp_shift(bflo(L.ck[1]), bflo(L.pk[1]), mu_k[2]); k4[3] = lerp_shift(bfhi(L.ck[1]), bfhi(L.pk[1]), mu_k[3]);
            vv[0] = lerp_shift(bflo(L.cv[0]), bflo(L.pv[0]), mu_v[0]); vv[1] = lerp_shift(bfhi(L.cv[0]), bfhi(L.pv[0]), mu_v[1]); vv[2] = lerp_shift(bflo(L.cv[1]), bflo(L.pv[1]), mu_v[2]); vv[3] = lerp_shift(bfhi(L.cv[1]), bfhi(L.pv[1]), mu_v[3]);
            const f32x4 wpre = *(const LAS f32x4*)(LP + (0 * CH + tok) * 64 + c4) + *(const LAS f32x4*)(LP + (1 * CH + tok) * 64 + c4);
            const f32x4 apre = *(const LAS f32x4*)(LP + (2 * CH + tok) * 64 + c4) + *(const LAS f32x4*)(LP + (3 * CH + tok) * 64 + c4);
            f32x4 dec, av, kkn, km;
            float ssk = 0.f;
#pragma unroll
            for (int j = 0; j < 4; ++j) {
                dec[j] = __builtin_amdgcn_exp2f(-0.8750387749145276f * fast_sigmoid(w0v[j] + wpre[j]));
                av[j] = fast_sigmoid(a0v[j] + apre[j]);
                kkn[j] = k4[j] * kkv[j]; ssk += kkn[j] * kkn[j];
                km[j] = k4[j] * (1.0f + (av[j] - 1.0f) * kav[j]);
            }
            ssk = row16_sum(ssk);
            const float kinv = 1.0f / sqrtf(fmaxf(ssk, 1e-24f));
            f32x4 nkk, kka, wr; float c1 = 0.f, c2 = 0.f, rk = 0.f;
#pragma unroll
            for (int j = 0; j < 4; ++j) { const float kn = kkn[j] * kinv; nkk[j] = -kn; kka[j] = kn * av[j]; wr[j] = dec[j] * r4[j]; c1 += kka[j] * r4[j]; c2 += km[j] * r4[j]; rk += r4[j] * km[j] * rkv[j]; }
            c1 = row16_sum(c1); c2 = row16_sum(c2); rk = row16_sum(rk);
            LAS float* sb = SB + tok * SBW;
            *(LAS f32x4*)(sb + c4) = dec; *(LAS f32x4*)(sb + 64 + c4) = nkk; *(LAS f32x4*)(sb + 128 + c4) = kka; *(LAS f32x4*)(sb + 192 + c4) = km; *(LAS f32x4*)(sb + 256 + c4) = wr; *(LAS f32x4*)(sb + 320 + c4) = vv;
            if (cg == 0) { f32x2 cc2 = {c1, c2}; *(LAS f32x2*)(sb + 384) = cc2; }
            if (own) {
                const int o = tok * 16 + c4 - 16 * q;
                const f32x4 g4 = (*(const LAS f32x4*)(LGP + 0 * CH * 16 + o) + *(const LAS f32x4*)(LGP + 1 * CH * 16 + o)) + (*(const LAS f32x4*)(LGP + 2 * CH * 16 + o) + *(const LAS f32x4*)(LGP + 3 * CH * 16 + o));
                const f32x4 ta = gnw * g4, tbv = (gnb + vv * rk) * g4;
                u32x2 wa, wb; wa[0] = pk2(ta[0], ta[1]); wa[1] = pk2(ta[2], ta[3]); wb[0] = pk2(tbv[0], tbv[1]); wb[1] = pk2(tbv[2], tbv[3]);
                *(u32x2*)(bufA + tg * RWD + hc) = wa; *(u32x2*)(bufB + tg * RWD + hc) = wb;
            }
        }
        __syncthreads();
      }
        if (t0 + CH < SEQ) RW_LOAD(t0 + CH);
      for (int repc = 0; repc < RW_REP_C; ++repc) {
        float s0k = s0, s1k = s1;
        {
            const LAS float* sbl = SB + 2 * l32; const LAS float* sbv = SB + 320 + 16 * q + rl;
            f32x2 dec = *(const LAS f32x2*)(sbl), nkk = *(const LAS f32x2*)(sbl + 64), kka = *(const LAS f32x2*)(sbl + 128), km = *(const LAS f32x2*)(sbl + 192), wr = *(const LAS f32x2*)(sbl + 256);
            float v = sbv[0]; f32x2 c12 = *(const LAS f32x2*)(SB + 384);
            float ykeep = 0.f;
#pragma unroll 4
            for (int i = 0; i < CH; ++i) {
                const int in = (i + 1 < CH ? i + 1 : i) * SBW;
                const f32x2 dec_n = *(const LAS f32x2*)(sbl + in), nkk_n = *(const LAS f32x2*)(sbl + in + 64), kka_n = *(const LAS f32x2*)(sbl + in + 128), km_n = *(const LAS f32x2*)(sbl + in + 192), wr_n = *(const LAS f32x2*)(sbl + in + 256);
                const float v_n = sbv[in]; const f32x2 c12_n = *(const LAS f32x2*)(SB + in + 384);
                const float pa = s0 * nkk[0] + s1 * nkk[1], pu = s0 * wr[0] + s1 * wr[1];
                auto r1 = __builtin_amdgcn_permlane16_swap(__builtin_bit_cast(unsigned, pa), __builtin_bit_cast(unsigned, pu), false, false);
                const float x = row16_sum(__builtin_bit_cast(float, (unsigned)r1[0]) + __builtin_bit_cast(float, (unsigned)r1[1]));
                const unsigned xu = __builtin_bit_cast(unsigned, x);
                auto r2 = __builtin_amdgcn_permlane16_swap(xu, xu, false, false);
                const float sa = __builtin_bit_cast(float, (unsigned)r2[0]), u = __builtin_bit_cast(float, (unsigned)r2[1]);
                s0 = s0 * dec[0] + (kka[0] * sa + km[0] * v);
                s1 = s1 * dec[1] + (kka[1] * sa + km[1] * v);
                const float y = u + sa * c12[0] + v * c12[1];
                ykeep = (l32 == i) ? y : ykeep;
                dec = dec_n; nkk = nkk_n; kka = kka_n; km = km_n; wr = wr_n; v = v_n; c12 = c12_n;
            }
            Y[l32 * 16 + rl] = ykeep;
        }
        __syncthreads();
        if (repc + 1 < RW_REP_C) { s0 = s0k; s1 = s1k; }
      }
        if (tid < 128) { const int tk = tid >> 2, rg = tid & 3; const f32x4 y4 = *(const LAS f32x4*)(Y + tk * 16 + 4 * rg);
            u32x2 wq; wq[0] = pk2(y4[0], y4[1]); wq[1] = pk2(y4[2], y4[3]);
            *(u32x2*)(ycat + (tb + t0 + tk) * YC + 64 * h + 16 * q + 4 * rg) = wq; }
    }
#undef RW_LOAD
}


typedef short v4i16_t __attribute__((ext_vector_type(4)));
constexpr int PB = 144, PX = 272, PF = 272;
constexpr int MB = 64 * PB;
constexpr int O_AT = 0, O_BT = MB, O_KT = 2 * MB, O_RT = 3 * MB, O_VM = 4 * MB;
constexpr int O_LW = 5 * MB, O_LA = O_LW + 64 * PF, O_LG = O_LA + 64 * PF, O_CL = O_LG + 64 * PF;
constexpr int O_P1 = 5 * MB, O_P2 = 6 * MB, O_P3 = 7 * MB, O_P4 = 8 * MB, O_PD = 9 * MB, O_DP = O_PD  , O_R2 = O_PD + 4096, O_YB = O_R2 + 64 * PF, O_X = O_YB + 64 * PF;
constexpr int O_GAM = O_X + 64 * PX, O_MC0 = O_GAM + 256, O_GC0 = O_MC0 + MB, O_CONST = O_GC0 + MB, O_RWK_END = O_CONST + 896 * 4;
constexpr int O_RW = O_AT, O_MM = O_P1, O_GM = O_P2, O_YT = O_R2;
constexpr int O_ST = O_MC0;
constexpr int O_S0 = 0, O_CM = 2 * MB, O_CG = 3 * MB;
static_assert(O_CL + 64 * 65 * 4 <= O_GAM && O_RWK_END <= MISC_OFF, "rwkv LDS map");

__device__ __forceinline__ bf16x8 frag_c(const LAS unsigned char* X, int P, int r0, int c0, int lane) {
    return *(const LAS bf16x8*)(X + (r0 + (lane & 15)) * P + (c0 + 8 * (lane >> 4)) * 2);
}
__device__ __forceinline__ bf16x8 frag_t(const LAS unsigned char* X, int P, int r0, int c0, int lane) {
    const int i = lane & 15, q = lane >> 4;
    const LAS unsigned char* p = X + (r0 + 8 * q + (i >> 2)) * P + (c0 + 4 * (i & 3)) * 2;
    const v4i16_t lo = __builtin_amdgcn_ds_read_tr16_b64_v4i16((LAS v4i16_t*)p), hi = __builtin_amdgcn_ds_read_tr16_b64_v4i16((LAS v4i16_t*)(p + 4 * P));
    return (bf16x8){lo[0], lo[1], lo[2], lo[3], hi[0], hi[1], hi[2], hi[3]};
}
#define MFMA16(a, b, c) __builtin_amdgcn_mfma_f32_16x16x32_bf16((a), (b), (c), 0, 0, 0)
__device__ __forceinline__ unsigned short bf1(float x) { return (unsigned short)(pk2(x, 0.f) & 0xffffu); }
__device__ __forceinline__ void st_bf(LAS unsigned char* X, int P, int m0, int n0, const f32x4 a, int lane) {
    LAS unsigned short* p = (LAS unsigned short*)(X + (m0 + 4 * (lane >> 4)) * P + (n0 + (lane & 15)) * 2);
#pragma unroll
    for (int r = 0; r < 4; ++r) p[r * (P / 2)] = bf1(a[r]);
}
__device__ __forceinline__ void st_f32(LAS unsigned char* X, int P, int m0, int n0, const f32x4 a, int lane) {
    LAS float* p = (LAS float*)(X + (m0 + 4 * (lane >> 4)) * P + (n0 + (lane & 15)) * 4);
#pragma unroll
    for (int r = 0; r < 4; ++r) p[r * (P / 4)] = a[r];
}
__device__ __forceinline__ f32x4 ld_bf(const LAS unsigned char* X, int P, int m0, int n0, int lane) {
    const LAS unsigned short* p = (const LAS unsigned short*)(X + (m0 + 4 * (lane >> 4)) * P + (n0 + (lane & 15)) * 2);
    f32x4 a;
#pragma unroll
    for (int r = 0; r < 4; ++r) a[r] = __uint_as_float((unsigned)p[r * (P / 2)] << 16);
    return a;
}
__device__ __forceinline__ f32x4 ld_f32(const LAS unsigned char* X, int P, int m0, int n0, int lane) {
    const LAS float* p = (const LAS float*)(X + (m0 + 4 * (lane >> 4)) * P + (n0 + (lane & 15)) * 4);
    f32x4 a;
#pragma unroll
    for (int r = 0; r < 4; ++r) a[r] = p[r * (P / 4)];
    return a;
}
__device__ __forceinline__ u32x2 pack4(const f32x4 a) { u32x2 w; w[0] = pk2(a[0], a[1]); w[1] = pk2(a[2], a[3]); return w; }
__device__ __forceinline__ f32x4 unpack4(const u32x2 w) { return (f32x4){bflo(w[0]), bfhi(w[0]), bflo(w[1]), bfhi(w[1])}; }
__device__ __forceinline__ float row8_sum(float v) {
    v += __builtin_bit_cast(float, __builtin_amdgcn_update_dpp(0, __builtin_bit_cast(int, v), 0xB1, 0xF, 0xF, true));
    v += __builtin_bit_cast(float, __builtin_amdgcn_update_dpp(0, __builtin_bit_cast(int, v), 0x4E, 0xF, 0xF, true));
    v += __builtin_bit_cast(float, __builtin_amdgcn_update_dpp(0, __builtin_bit_cast(int, v), 0x141, 0xF, 0xF, true));
    return v;
}
__device__ __forceinline__ float dpp_shr(float v, int) = delete;
#define DPP_SHR1(v) __builtin_bit_cast(float, __builtin_amdgcn_update_dpp(0, __builtin_bit_cast(int, (v)), 0x111, 0xF, 0xF, true))
#define DPP_SHR2(v) __builtin_bit_cast(float, __builtin_amdgcn_update_dpp(0, __builtin_bit_cast(int, (v)), 0x112, 0xF, 0xF, true))
#define DPP_SHR4(v) __builtin_bit_cast(float, __builtin_amdgcn_update_dpp(0, __builtin_bit_cast(int, (v)), 0x114, 0xF, 0xF, true))
#define WG_BAR() __syncthreads()

template <class BarT>
__device__ __forceinline__ void rwkv_chunked(const Args& A, unsigned char* ws, int b, int h, int qd, LAS unsigned char* lds, const BarT& gridbar) {
    const int tid = threadIdx.x, lane0 = tid & 63, w = __builtin_amdgcn_readfirstlane(tid >> 6);
    int lane = lane0, li = lane & 15, lq = lane >> 4;
#define LANE_FENCE() do { lane = lane0; asm volatile("" : "+v"(lane)); li = lane & 15; lq = lane >> 4; } while (0)
    const bf16_t* zr = (const bf16_t*)(ws + WS_D);
    bf16_t* ycat = (bf16_t*)(ws + WS_XB); bf16_t* bufA = (bf16_t*)(ws + WS_BUFA); bf16_t* bufB = (bf16_t*)(ws + WS_BUFB);
    bf16_t* comp = (bf16_t*)(ws + WS_COMP);
    const bf16_t* w2t = (const bf16_t*)(ws + WS_LORA); const bf16_t* a2t = w2t + 512 * 64; const bf16_t* g2t = a2t + 512 * 64;
    const float* mu = A.in[IN_MU];
    const size_t tb = (size_t)b * SEQ;
    {
        LAS float* cst = (LAS float*)(lds + O_CONST);
        for (int e = tid; e < 896; e += 512) {
            float v;
            if (e < 640) { const int wh = e >> 6, c = 64 * h + (e & 63);
                const float* src = wh == 0 ? A.in[IN_W0] : wh == 1 ? A.in[IN_A0] : wh == 2 ? A.in[IN_KK] : wh == 3 ? A.in[IN_KA] : wh == 4 ? A.in[IN_RK] : wh == 5 ? A.in[IN_GNW] : wh == 6 ? A.in[IN_GNB] : mu;
                v = src[wh < 7 ? c : (wh - 7) * 512 + c]; }
            else v = mu[1536 + (e - 640)];
            cst[e] = v;
        }
    }
    u32x4 zq[8], zcr, zck, zcv, zpr, zpk, zpv;
#define RWK_PREFETCH(t0_) do { \
        { const int tp_ = (t0_) + 16 * (w >> 1) + (lane0 & 15); const bf16_t* zc_ = zr + (tb + tp_) * RWC; const bf16_t* zp_ = tp_ > 0 ? zc_ - RWC : zc_; const unsigned pm_ = tp_ > 0 ? 0xffffffffu : 0u; \
          _Pragma("unroll") for (int k_ = 0; k_ < 4; ++k_) { const int col_ = 1536 + 128 * (w & 1) + 32 * k_ + 8 * (lane0 >> 4); \
              zq[2 * k_] = *(const u32x4*)(zc_ + col_); zq[2 * k_ + 1] = *(const u32x4*)(zp_ + col_); \
              zq[2 * k_ + 1][0] &= pm_; zq[2 * k_ + 1][1] &= pm_; zq[2 * k_ + 1][2] &= pm_; zq[2 * k_ + 1][3] &= pm_; } } \
        { const int hc_ = 64 * h + 8 * (tid & 7); const int tp_ = (t0_) + (tid >> 3); const bf16_t* zc_ = zr + (tb + tp_) * RWC; const bf16_t* zp_ = tp_ > 0 ? zc_ - RWC : zc_; const unsigned pm_ = tp_ > 0 ? 0xffffffffu : 0u; \
          zcr = *(const u32x4*)(zc_ + hc_); zck = *(const u32x4*)(zc_ + 512 + hc_); zcv = *(const u32x4*)(zc_ + 1024 + hc_); \
          zpr = *(const u32x4*)(zp_ + hc_); zpk = *(const u32x4*)(zp_ + 512 + hc_); zpv = *(const u32x4*)(zp_ + 1024 + hc_); \
          _Pragma("unroll") for (int e_ = 0; e_ < 4; ++e_) { zpr[e_] &= pm_; zpk[e_] &= pm_; zpv[e_] &= pm_; } } } while (0)
    RWK_PREFETCH(512 * qd);
    WG_BAR();
    for (int pass = 0; pass < 2; ++pass) {
    for (int j = 0; j < 8; ++j) {
        const int t0 = 512 * qd + 64 * j;
#ifndef RWK_REP0
#define RWK_REP0 1
#endif
#ifndef RWK_REP14
#define RWK_REP14 1
#endif
      for (int rep0 = 0; rep0 < RWK_REP0; ++rep0) {
        LANE_FENCE();
        {
            const int tt = w >> 1, cp = w & 1;
            const LAS float* cmu = (const LAS float*)(lds + O_CONST) + 640 + 128 * cp + 8 * lq;
            f32x4 acc[2][4];
#pragma unroll
            for (int m = 0; m < 2; ++m)
#pragma unroll
                for (int c4 = 0; c4 < 4; ++c4) acc[m][c4] = (f32x4){0.f, 0.f, 0.f, 0.f};
#pragma unroll
            for (int k4 = 0; k4 < 4; ++k4) {
                float c[8], p[8], x[8]; unpack8(zq[2 * k4], c); unpack8(zq[2 * k4 + 1], p);
                const f32x4 m0 = *(const LAS f32x4*)(cmu + 32 * k4), m1 = *(const LAS f32x4*)(cmu + 32 * k4 + 4);
#pragma unroll
                for (int e = 0; e < 8; ++e) { const float xv = lerp_shift(c[e], p[e], e < 4 ? m0[e] : m1[e - 4]);
                    const float th = 1.0f - 2.0f * __builtin_amdgcn_rcpf(1.0f + __builtin_amdgcn_exp2f(xv * 2.8853900817779268f));
                    x[e] = cp ? fast_sigmoid(xv) : (k4 < 2 ? th : xv); }
                const bf16x8 af = pack8(x);
                const bf16_t* wt = cp ? g2t : (k4 < 2 ? w2t : a2t); const int kw = cp ? 128 : 64, kk = cp ? k4 : (k4 & 1), mi = cp ? 0 : (k4 >> 1);
#pragma unroll
                for (int c4 = 0; c4 < 4; ++c4) {
                    const bf16x8 bfr = *(const bf16x8*)(wt + (size_t)(64 * h + 16 * c4 + li) * kw + 32 * kk + 8 * lq);
                    acc[mi][c4] = MFMA16(af, bfr, acc[mi][c4]);
                }
            }
#pragma unroll
            for (int c4 = 0; c4 < 4; ++c4) {
                if (cp) st_f32(lds + O_LG, PF, 16 * tt, 16 * c4, acc[0][c4], lane);
                else { st_f32(lds + O_LW, PF, 16 * tt, 16 * c4, acc[0][c4], lane); st_f32(lds + O_LA, PF, 16 * tt, 16 * c4, acc[1][c4], lane); }
            }
        }
        WG_BAR();
        LANE_FENCE();
        {
            const int tk = tid >> 3, c8 = tid & 7, hc = 64 * h + 8 * c8; const LAS float* cst = (const LAS float*)(lds + O_CONST);
            const int tpos = t0 + tk; const size_t tg = tb + tpos; const bf16_t* zc = zr + tg * RWC; const bool hp = tpos > 0;
            float r8[8], k8[8], v8[8], lw8[8], av8[8], bv8[8];
            {
                const u32x4 cr = zcr, ck = zck, cv = zcv, pr = zpr, pk = zpk, pv = zpv;
                float c[8], p[8];
                unpack8(cr, c); unpack8(pr, p);
                { const f32x4 m0 = *(const LAS f32x4*)(cst + 448 + 8 * c8), m1 = *(const LAS f32x4*)(cst + 448 + 8 * c8 + 4);
#pragma unroll
                  for (int e = 0; e < 8; ++e) r8[e] = lerp_shift(c[e], p[e], e < 4 ? m0[e] : m1[e - 4]); }
                unpack8(ck, c); unpack8(pk, p);
                { const f32x4 m0 = *(const LAS f32x4*)(cst + 512 + 8 * c8), m1 = *(const LAS f32x4*)(cst + 512 + 8 * c8 + 4);
#pragma unroll
                  for (int e = 0; e < 8; ++e) k8[e] = lerp_shift(c[e], p[e], e < 4 ? m0[e] : m1[e - 4]); }
                unpack8(cv, c); unpack8(pv, p);
                { const f32x4 m0 = *(const LAS f32x4*)(cst + 576 + 8 * c8), m1 = *(const LAS f32x4*)(cst + 576 + 8 * c8 + 4);
#pragma unroll
                  for (int e = 0; e < 8; ++e) v8[e] = lerp_shift(c[e], p[e], e < 4 ? m0[e] : m1[e - 4]); }
            }
            float ssk = 0.f, rk = 0.f;
            {
                const LAS float* lwp = (const LAS float*)(lds + O_LW + tk * PF) + 8 * c8; const LAS float* lap = (const LAS float*)(lds + O_LA + tk * PF) + 8 * c8;
#pragma unroll
                for (int e = 0; e < 8; ++e) {
                    lw8[e] = -0.6065306597126334f * fast_sigmoid(cst[8 * c8 + e] + lwp[e]);
                    av8[e] = fast_sigmoid(cst[64 + 8 * c8 + e] + lap[e]);
                    const float kn = k8[e] * cst[128 + 8 * c8 + e]; ssk += kn * kn; bv8[e] = kn;
                    k8[e] = k8[e] * (1.0f + (av8[e] - 1.0f) * cst[192 + 8 * c8 + e]);
                    rk += r8[e] * k8[e] * cst[256 + 8 * c8 + e];
                }
            }
            ssk = row8_sum(ssk); rk = row8_sum(rk);
            const float kinv = 1.0f / sqrtf(fmaxf(ssk, 1e-24f));
#pragma unroll
            for (int e = 0; e < 8; ++e) { const float kn = bv8[e] * kinv; bv8[e] = kn * av8[e]; av8[e] = -kn; }
            {
                const LAS float* lgp = (const LAS float*)(lds + O_LG + tk * PF) + 8 * c8; float ta[8], tbv[8];
#pragma unroll
                for (int e = 0; e < 8; ++e) { const float g = lgp[e]; ta[e] = cst[320 + 8 * c8 + e] * g; tbv[e] = (cst[384 + 8 * c8 + e] + rk * v8[e]) * g; }
                if (pass) { *(bf16x8*)(bufA + tg * RWD + hc) = pack8(ta); *(bf16x8*)(bufB + tg * RWD + hc) = pack8(tbv); }
                *(LAS bf16x8*)(lds + O_VM + tk * PB + 16 * c8) = pack8(v8);
            }
            {   LAS float* cl = (LAS float*)(lds + O_CL) + tk * 65 + 8 * c8;
#pragma unroll
                for (int e = 0; e < 8; ++e) cl[e] = lw8[e]; }
            WG_BAR();
            {
                const int cc = tid >> 3, sg = tid & 7; LAS float* cl = (LAS float*)(lds + O_CL) + (8 * sg) * 65 + cc;
                float pf[8]; float run = 0.f;
#pragma unroll
                for (int e = 0; e < 8; ++e) { run += cl[e * 65]; pf[e] = run; }
                float sc = run, tsh;
                tsh = DPP_SHR1(sc); if (sg >= 1) sc += tsh;
                tsh = DPP_SHR2(sc); if (sg >= 2) sc += tsh;
                tsh = DPP_SHR4(sc); if (sg >= 4) sc += tsh;
                const float off = sc - run;
#pragma unroll
                for (int e = 0; e < 8; ++e) cl[e * 65] = pf[e] + off;
            }
            WG_BAR();
            {
                const LAS float* cl = (const LAS float*)(lds + O_CL) + tk * 65 + 8 * c8;
                float xa[8], xb[8], xk[8], xr[8];
#pragma unroll
                for (int e = 0; e < 8; ++e) { const float c = cl[e] * 1.4426950408889634f, cp = c - lw8[e] * 1.4426950408889634f;
                    const float ei = __builtin_amdgcn_exp2f(-c), ef = __builtin_amdgcn_exp2f(c), ep = __builtin_amdgcn_exp2f(cp);
                    xa[e] = av8[e] * ep; xb[e] = bv8[e] * ei; xk[e] = k8[e] * ei; xr[e] = r8[e] * ef;
                    if (tk == 63) ((LAS float*)(lds + O_GAM))[8 * c8 + e] = ef; }
                *(LAS bf16x8*)(lds + O_AT + tk * PB + 16 * c8) = pack8(xa); *(LAS bf16x8*)(lds + O_BT + tk * PB + 16 * c8) = pack8(xb);
                *(LAS bf16x8*)(lds + O_KT + tk * PB + 16 * c8) = pack8(xk); *(LAS bf16x8*)(lds + O_RT + tk * PB + 16 * c8) = pack8(xr);
            }
        }
        WG_BAR();
      }
        { const int itn = pass * 8 + j + 1; if (itn < 16) RWK_PREFETCH(512 * qd + 64 * (itn & 7)); }
      for (int rp1 = 0; rp1 < RWK_REP14; ++rp1) {
        LANE_FENCE();
        {
            const int p = w >> 1, half = w & 1;
            if (pass || p < 2) {
            const LAS unsigned char* Am = lds + (p < 2 ? O_AT : O_RT); const LAS unsigned char* Bm = lds + ((p & 1) ? O_KT : O_BT);
            LAS unsigned char* Pm = lds + O_P1 + p * MB;
#pragma unroll
            for (int rr = 0; rr < 2; ++rr) {
                const int rt = half ? 1 + rr : 3 * rr;
#pragma unroll
                for (int ct = 0; ct < 4; ++ct) {
                    f32x4 acc = {0.f, 0.f, 0.f, 0.f};
                    if (ct <= rt) {
#pragma unroll
                        for (int ks = 0; ks < 2; ++ks) acc = MFMA16(frag_c(Am, PB, 16 * rt, 32 * ks, lane), frag_c(Bm, PB, 16 * ct, 32 * ks, lane), acc);
                        if (ct == rt) {
#pragma unroll
                            for (int r = 0; r < 4; ++r) { const int m = 4 * lq + r; const bool keep = p < 2 ? (m > li) : (m >= li); if (!keep) acc[r] = 0.f; }
                        }
                    }
                    if (p == 0 && ct == rt) { st_f32(lds + O_PD + rt * 1024, 64, 0, 0, acc, lane); acc = (f32x4){0.f, 0.f, 0.f, 0.f}; }
                    st_bf(Pm, PB, 16 * rt, 16 * ct, acc, lane);
                }
            }
            }
            for (int e = tid; e < 64 * PX / 16; e += 512) ((LAS u32x4*)(lds + O_X))[e] = (u32x4){0u, 0u, 0u, 0u};
        }
        WG_BAR();
      }
        LANE_FENCE();
        if (w < 7) {
            for (int tile = w; tile < (pass ? 32 : 16); tile += 7) {
                f32x4 acc = {0.f, 0.f, 0.f, 0.f};
                if (tile < 16) { const int rt = tile >> 2, ct = tile & 3;
#pragma unroll
                    for (int ks = 0; ks < 2; ++ks) acc = MFMA16(frag_c(lds + O_P2, PB, 16 * rt, 32 * ks, lane), frag_t(lds + O_VM, PB, 32 * ks, 16 * ct, lane), acc);
                    st_f32(lds + O_R2, PF, 16 * rt, 16 * ct, acc, lane);
                } else { const int vt = (tile - 16) >> 2, tt = tile & 3;
#pragma unroll
                    for (int ks = 0; ks < 2; ++ks) acc = MFMA16(frag_t(lds + O_VM, PB, 32 * ks, 16 * vt, lane), frag_c(lds + O_P4, PB, 16 * tt, 32 * ks, lane), acc);
                    st_f32(lds + O_YB, PF, 16 * vt, 16 * tt, acc, lane);
                }
            }
        } else {
            const LAS float* L = (const LAS float*)(lds + O_PD) + lq * 256;
            float d[16];
#pragma unroll
            for (int r = 0; r < 16; ++r) d[r] = (r == li) ? 1.f : 0.f;
#pragma unroll
            for (int u = 0; u < 15; ++u) {
#pragma unroll
                for (int r = u + 1; r < 16; ++r) d[r] += L[r * 16 + u] * d[u];
            }
            LAS unsigned short* dp = (LAS unsigned short*)(lds + O_DP) + lq * 512 + (li >> 2) * 8 + (li & 3);
#pragma unroll
            for (int r = 0; r < 16; ++r) { dp[r * 32] = bf1(d[r]); dp[r * 32 + 4] = 0; }
        }
        WG_BAR();
      for (int rp3 = 0; rp3 < RWK_REP14; ++rp3) {
        LANE_FENCE();
        {
#pragma unroll
            for (int i = 0; i < 4; ++i) {
                f32x4 acc = w < 4 ? ld_bf(lds + O_AT, PB, 16 * i, 16 * w, lane) : ld_f32(lds + O_R2, PF, 16 * i, 16 * (w - 4), lane);
                if (i >= 1) acc = MFMA16(frag_c(lds + O_P1, PB, 16 * i, 0, lane), frag_t(lds + O_X, PX, 0, 16 * w, lane), acc);
                if (i == 3) acc = MFMA16(frag_c(lds + O_P1, PB, 16 * i, 32, lane), frag_t(lds + O_X, PX, 32, 16 * w, lane), acc);
                u32x4 bw; bw[0] = pk2(acc[0], acc[1]); bw[1] = pk2(acc[2], acc[3]); bw[2] = 0u; bw[3] = 0u;
                const bf16x8 df = *(const LAS bf16x8*)(lds + O_DP + i * 1024 + li * 64 + lq * 16);
                const f32x4 x = MFMA16(df, __builtin_bit_cast(bf16x8, bw), ((f32x4){0.f, 0.f, 0.f, 0.f}));
                st_bf(lds + O_X, PX, 16 * i, 16 * w, x, lane);
                WG_BAR();
            }
        }
      }
      for (int rp4 = 0; rp4 < RWK_REP14; ++rp4) {
        LANE_FENCE();
        {
            const int o = w >> 1, half = w & 1;
            if (pass || o >= 2) {
            const LAS float* gam = (const LAS float*)(lds + O_GAM);
#pragma unroll
            for (int rr = 0; rr < 2; ++rr) {
                const int rt = 2 * half + rr;
#pragma unroll
                for (int ct = 0; ct < 4; ++ct) {
                    f32x4 acc;
                    if (o == 0) {
                        acc = ld_bf(lds + O_RT, PB, 16 * rt, 16 * ct, lane);
#pragma unroll
                        for (int ks = 0; ks < 2; ++ks) acc = MFMA16(frag_c(lds + O_P3, PB, 16 * rt, 32 * ks, lane), frag_t(lds + O_X, PX, 32 * ks, 16 * ct, lane), acc);
                        st_bf(lds + O_RW, PB, 16 * rt, 16 * ct, acc, lane);
                    } else if (o == 1) {
                        acc = ld_f32(lds + O_YB, PF, 16 * rt, 16 * ct, lane);
#pragma unroll
                        for (int ks = 0; ks < 2; ++ks) acc = MFMA16(frag_t(lds + O_X, PX, 32 * ks, 64 + 16 * rt, lane), frag_c(lds + O_P3, PB, 16 * ct, 32 * ks, lane), acc);
                        st_bf(lds + O_YT, PB, 16 * rt, 16 * ct, acc, lane);
                    } else if (o == 2) {
                        acc = (f32x4){0.f, 0.f, 0.f, 0.f};
#pragma unroll
                        for (int ks = 0; ks < 2; ++ks) acc = MFMA16(frag_t(lds + O_X, PX, 32 * ks, 16 * rt, lane), frag_t(lds + O_BT, PB, 32 * ks, 16 * ct, lane), acc);
                        const float gc = gam[16 * ct + li];
#pragma unroll
                        for (int r = 0; r < 4; ++r) acc[r] = (acc[r] + ((16 * rt + 4 * lq + r) == (16 * ct + li) ? 1.f : 0.f)) * gc;
                        st_bf(lds + O_MM, PB, 16 * rt, 16 * ct, acc, lane);
                    } else {
                        acc = (f32x4){0.f, 0.f, 0.f, 0.f};
#pragma unroll
                        for (int ks = 0; ks < 2; ++ks) { acc = MFMA16(frag_t(lds + O_X, PX, 32 * ks, 64 + 16 * rt, lane), frag_t(lds + O_BT, PB, 32 * ks, 16 * ct, lane), acc);
                            acc = MFMA16(frag_t(lds + O_VM, PB, 32 * ks, 16 * rt, lane), frag_t(lds + O_KT, PB, 32 * ks, 16 * ct, lane), acc); }
                        const float gc = gam[16 * ct + li];
                        acc = acc * gc;
                        st_bf(lds + O_GM, PB, 16 * rt, 16 * ct, acc, lane);
                    }
                }
            }
            }
        }
        WG_BAR();
      }
        LANE_FENCE();
        if (pass == 0) {
            if (j == 0) { for (int e = tid; e < MB / 16; e += 512) { ((LAS u32x4*)(lds + O_MC0))[e] = ((const LAS u32x4*)(lds + O_MM))[e]; ((LAS u32x4*)(lds + O_GC0))[e] = ((const LAS u32x4*)(lds + O_GM))[e]; } }
            else {
                f32x4 am[2], ag[2];
#pragma unroll
                for (int tl = 0; tl < 2; ++tl) { const int tile = 2 * w + tl, rt = tile >> 2, ct = tile & 3;
                    am[tl] = (f32x4){0.f, 0.f, 0.f, 0.f}; ag[tl] = ld_bf(lds + O_GM, PB, 16 * rt, 16 * ct, lane);
#pragma unroll
                    for (int ks = 0; ks < 2; ++ks) { const bf16x8 bm = frag_t(lds + O_MM, PB, 32 * ks, 16 * ct, lane);
                        am[tl] = MFMA16(frag_c(lds + O_MC0, PB, 16 * rt, 32 * ks, lane), bm, am[tl]); ag[tl] = MFMA16(frag_c(lds + O_GC0, PB, 16 * rt, 32 * ks, lane), bm, ag[tl]); } }
                WG_BAR();
#pragma unroll
                for (int tl = 0; tl < 2; ++tl) { const int tile = 2 * w + tl, rt = tile >> 2, ct = tile & 3; st_bf(lds + O_MC0, PB, 16 * rt, 16 * ct, am[tl], lane); st_bf(lds + O_GC0, PB, 16 * rt, 16 * ct, ag[tl], lane); }
            }
        } else {
            f32x4 as[2];
#pragma unroll
            for (int tl = 0; tl < 2; ++tl) { const int tile = 2 * w + tl, rt = tile >> 2, ct = tile & 3;
                f32x4 ay = ld_bf(lds + O_YT, PB, 16 * rt, 16 * ct, lane);
                as[tl] = ld_bf(lds + O_GM, PB, 16 * rt, 16 * ct, lane);
#pragma unroll
                for (int ks = 0; ks < 2; ++ks) { const bf16x8 sf = frag_c(lds + O_ST, PB, 16 * rt, 32 * ks, lane);
                    ay = MFMA16(sf, frag_c(lds + O_RW, PB, 16 * ct, 32 * ks, lane), ay); as[tl] = MFMA16(sf, frag_t(lds + O_MM, PB, 32 * ks, 16 * ct, lane), as[tl]); }
                *(u32x2*)(ycat + (tb + t0 + 16 * ct + li) * YC + 64 * h + 16 * rt + 4 * lq) = pack4(ay); }
            WG_BAR();
#pragma unroll
            for (int tl = 0; tl < 2; ++tl) { const int tile = 2 * w + tl, rt = tile >> 2, ct = tile & 3; st_bf(lds + O_ST, PB, 16 * rt, 16 * ct, as[tl], lane); }
        }
        WG_BAR();
    }
    if (pass == 0) {
        bf16_t* cdst = comp + (size_t)((b * 8 + h) * 4 + qd) * 8192;
        for (int e = tid; e < 1024; e += 512) { const int mat = e >> 9, row = (e >> 3) & 63, ch = e & 7;
            *(u32x4*)(cdst + mat * 4096 + row * 64 + ch * 8) = *(const LAS u32x4*)(lds + (mat ? O_GC0 : O_MC0) + row * PB + ch * 16); }
        gridbar();
        LANE_FENCE();
        for (int e = tid; e < MB / 16; e += 512) ((LAS u32x4*)(lds + O_S0))[e] = (u32x4){0u, 0u, 0u, 0u};
        WG_BAR();
        int cur = 0;
        for (int p = 0; p < qd; ++p) {
            const bf16_t* csrc = comp + (size_t)((b * 8 + h) * 4 + p) * 8192;
            for (int e = tid; e < 1024; e += 512) { const int mat = e >> 9, row = (e >> 3) & 63, ch = e & 7;
                *(LAS u32x4*)(lds + (mat ? O_CG : O_CM) + row * PB + ch * 16) = *(const u32x4*)(csrc + mat * 4096 + row * 64 + ch * 8); }
            WG_BAR();
#pragma unroll
            for (int tl = 0; tl < 2; ++tl) { const int tile = 2 * w + tl, rt = tile >> 2, ct = tile & 3;
                f32x4 acc = ld_bf(lds + O_CG, PB, 16 * rt, 16 * ct, lane);
#pragma unroll
                for (int ks = 0; ks < 2; ++ks) acc = MFMA16(frag_c(lds + O_S0 + cur * MB, PB, 16 * rt, 32 * ks, lane), frag_t(lds + O_CM, PB, 32 * ks, 16 * ct, lane), acc);
                st_bf(lds + O_S0 + (cur ^ 1) * MB, PB, 16 * rt, 16 * ct, acc, lane); }
            WG_BAR();
            cur ^= 1;
        }
        for (int e = tid; e < MB / 16; e += 512) ((LAS u32x4*)(lds + O_ST))[e] = ((const LAS u32x4*)(lds + O_S0 + cur * MB))[e];
        WG_BAR();
    }
    }
    asm volatile("s_waitcnt vmcnt(0)" ::: "memory"); WG_BAR();
    for (int it = 0; it < 16; ++it) {
        const size_t t = tb + 512 * qd + 32 * it + (tid >> 4); const int c4 = 64 * h + 4 * (tid & 15);
        const u32x2 yq = *(const u32x2*)(ycat + t * YC + c4), aq = *(const u32x2*)(bufA + t * RWD + c4), bq = *(const u32x2*)(bufB + t * RWD + c4);
        const f32x4 y4 = {bflo(yq[0]), bfhi(yq[0]), bflo(yq[1]), bfhi(yq[1])};
        const float mean = row16_sum((y4[0] + y4[1]) + (y4[2] + y4[3])) * (1.0f / 64.0f);
        const f32x4 d = y4 - mean;
        const float var = row16_sum((d[0] * d[0] + d[1] * d[1]) + (d[2] * d[2] + d[3] * d[3])) * (1.0f / 64.0f);
        const float rstd = 1.0f / sqrtf(var + GN_EPS);
        const f32x4 o = {d[0] * rstd * bflo(aq[0]) + bflo(bq[0]), d[1] * rstd * bfhi(aq[0]) + bfhi(bq[0]), d[2] * rstd * bflo(aq[1]) + bflo(bq[1]), d[3] * rstd * bfhi(aq[1]) + bfhi(bq[1])};
        u32x2 wq; wq[0] = pk2(o[0], o[1]); wq[1] = pk2(o[2], o[3]);
        *(u32x2*)(ycat + t * YC + c4) = wq;
    }
}

typedef short v4i16_t __attribute__((ext_vector_type(4)));
__device__ __forceinline__ int crow(int r, int hi) { return (r & 3) + 8 * (r >> 2) + 4 * hi; }
__device__ __forceinline__ void attn_item(bf16_t* Qa, const bf16_t* Ka, const bf16_t* Va, float* Lout, int it, float negbound, LAS unsigned char* vl, int lane, bool store = true) {
    const int bh = it >> 6, tile = it & 63, hh = bh % NAH, g = hh >> 2, Lg = SEQ >> (2 * g);
    const int f0 = tile * 32, l0 = f0 & (Lg - 1);
    const size_t base = (size_t)bh * SEQ * HD;
    const int r = lane & 31, h = lane >> 5;
    bf16_t* Qb = Qa + base + (size_t)f0 * HD;
    bf16x8 qf[4];
#pragma unroll
    for (int ks = 0; ks < 4; ++ks) qf[ks] = *(const bf16x8*)(Qb + r * HD + 16 * ks + 8 * h);
    f32x16 o0, o1; float lsum = 0.f;
#pragma unroll
    for (int i = 0; i < 16; ++i) { o0[i] = 0.f; o1[i] = 0.f; }
    const int jstart = l0 >= 128 ? 0 : (128 - l0) >> 5;
    const int g4 = lane >> 4, i16 = lane & 15;
    const int traddr = (4 * (g4 >> 1) + (i16 >> 2)) * 128 + (16 * (g4 & 1) + 4 * (i16 & 3)) * 2;
    for (int j = jstart; j < 5; ++j) {
        const int kf0 = f0 - 128 + 32 * j;
        const bf16_t* Kb = Ka + base + (size_t)kf0 * HD; const bf16_t* Vb = Va + base + (size_t)kf0 * HD;
        u32x4 vst[4];
#pragma unroll
        for (int i = 0; i < 4; ++i) vst[i] = *(const u32x4*)(Vb + ((lane >> 3) + 8 * i) * HD + (lane & 7) * 8);
        f32x16 s;
#pragma unroll
        for (int i = 0; i < 16; ++i) s[i] = negbound;
#pragma unroll
        for (int ks = 0; ks < 4; ++ks) { const bf16x8 kfr = *(const bf16x8*)(Kb + r * HD + 16 * ks + 8 * h); s = __builtin_amdgcn_mfma_f32_32x32x16_bf16(kfr, qf[ks], s, 0, 0, 0); }
#pragma unroll
        for (int i = 0; i < 4; ++i) *(LAS u32x4*)(vl + ((lane >> 3) + 8 * i) * 128 + (lane & 7) * 16) = vst[i];
        float p[16];
#pragma unroll
        for (int i = 0; i < 16; ++i) { const int kk = crow(i, h); const bool valid = (j == 0 ? kk >= r : true) && (j == 4 ? kk <= r : true); p[i] = valid ? __builtin_amdgcn_exp2f(s[i]) : 0.f; lsum += p[i]; }
        bf16x8 pa[2];
#pragma unroll
        for (int sx = 0; sx < 2; ++sx) { u32x4 wq; wq[0] = pk2(p[8 * sx + 0], p[8 * sx + 1]); wq[1] = pk2(p[8 * sx + 2], p[8 * sx + 3]); wq[2] = pk2(p[8 * sx + 4], p[8 * sx + 5]); wq[3] = pk2(p[8 * sx + 6], p[8 * sx + 7]); pa[sx] = __builtin_bit_cast(bf16x8, wq); }
#pragma unroll
        for (int mt = 0; mt < 2; ++mt)
#pragma unroll
            for (int sx = 0; sx < 2; ++sx) {
                const LAS unsigned char* ap = vl + traddr + sx * 16 * 128 + mt * 64;
                const v4i16_t lo = __builtin_amdgcn_ds_read_tr16_b64_v4i16((LAS v4i16_t*)ap), hi = __builtin_amdgcn_ds_read_tr16_b64_v4i16((LAS v4i16_t*)(ap + 8 * 128));
                const bf16x8 vf = {lo[0], lo[1], lo[2], lo[3], hi[0], hi[1], hi[2], hi[3]};
                if (mt == 0) o0 = __builtin_amdgcn_mfma_f32_32x32x16_bf16(vf, pa[sx], o0, 0, 0, 0); else o1 = __builtin_amdgcn_mfma_f32_32x32x16_bf16(vf, pa[sx], o1, 0, 0, 0);
            }
    }
    lsum += __shfl_xor(lsum, 32);
    if (!store) { asm volatile("" :: "v"(lsum), "v"(o0), "v"(o1)); return; }
    if (h == 0) Lout[(size_t)bh * SEQ + f0 + r] = lsum;
#pragma unroll
    for (int q4 = 0; q4 < 4; ++q4) {
        u32x2 w0, w1; w0[0] = pk2(o0[4 * q4], o0[4 * q4 + 1]); w0[1] = pk2(o0[4 * q4 + 2], o0[4 * q4 + 3]); w1[0] = pk2(o1[4 * q4], o1[4 * q4 + 1]); w1[1] = pk2(o1[4 * q4 + 2], o1[4 * q4 + 3]);
        *(u32x2*)(Qb + r * HD + 8 * q4 + 4 * h) = w0; *(u32x2*)(Qb + r * HD + 32 + 8 * q4 + 4 * h) = w1;
    }
}

struct GridBarFn { XcdBarrier b; __device__ __forceinline__ void operator()() const { xcd_barrier(b); } };
struct Ctx { LAS unsigned char* lds; unsigned char* ws; int tid, lane, wave, G, bx, gw, NGW; };

__device__ __forceinline__ void phase_prologue(const Args& args, const Ctx& c) {
    unsigned char* ws = c.ws;
    LAS float* scr = (LAS float*)(c.lds + c.wave * 16384);
    for (int it = c.gw; it < CONV_EARLY_ITEMS; it += c.NGW) {
        ConvSel s; s.found = false; s.W = nullptr; s.W2 = nullptr; s.gain = nullptr; s.WT = nullptr; s.ldw = 0; s.K = 64; s.ndst = 32; s.map = 0; s.item = 0; int r = it;
        CJ(args.in[IN_F1G], args.in[IN_F1U], args.in[IN_F1N], FF, DM, 2 * FF, MAP_CAT, (bf16_t*)(ws + WS_W1CAT))
        CJ(args.in[IN_W2], nullptr, nullptr, RWD, 64, RWD, MAP_PLAIN, (bf16_t*)(ws + WS_LORA))
        CJ(args.in[IN_A2], nullptr, nullptr, RWD, 64, RWD, MAP_PLAIN, (bf16_t*)(ws + WS_LORA) + 512 * 64)
        CJ(args.in[IN_G2], nullptr, nullptr, RWD, 128, RWD, MAP_PLAIN, (bf16_t*)(ws + WS_LORA) + 2 * 512 * 64)
        conv_item(s.W, s.W2, s.gain, s.ldw, s.K, s.ndst, s.map, s.WT, s.item, scr, c.lane);
    }
    bf16_t* xb = (bf16_t*)(ws + WS_XB); float* ssq = (float*)(ws + WS_SSQ);
    for (int m = c.gw; m < T; m += c.NGW) row_to_bf16_ssq(args.in[IN_X] + (size_t)m * DM, xb + (size_t)m * DM, ssq + (size_t)m * 16, c.lane);
    const int* pos = (const int*)args.in[IN_POS];
    float* cosT = (float*)(ws + WS_COS); float* sinT = (float*)(ws + WS_SIN);
    for (int e = c.bx * 512 + c.tid; e < T * 32; e += c.G * 512) {
        const int t = e >> 5, i = e & 31;
        const double inv = exp2(-(double)i * (13.287712379549449 / 32.0));
        const double ang = (double)pos[t] * inv;
        cosT[e] = (float)cos(ang); sinT[e] = (float)sin(ang);
    }
}
__device__ __forceinline__ void phase_swiglu(const Args& args, const Ctx& c, size_t ws_w, int which) {
    pg8::Gemm g{(const bf16_t*)(c.ws + WS_XB), (const bf16_t*)(c.ws + ws_w), DM, DM, T, 2 * FF, DM};
    pg8::StaticOrder S; S.init(T, 2 * FF, c.G, c.bx);
    pg8::EpiSwiglu E{(bf16_t*)(c.ws + WS_C), (const float*)(c.ws + WS_SSQ)};
    pg8::gemm_phase<pg8::EpiSwiglu, pg8::StaticOrder, ALIGN_MULTI, true>(c.lds, g, S, E);
    if (c.G == 256 && c.bx >= 128) {
        unsigned char* ws = c.ws; LAS float* scr = (LAS float*)(c.lds + c.wave * 16384);
        const int gw = (c.bx - 128) * NWAVES + c.wave, ngw = 128 * NWAVES;
        for (int it = gw; it < (which == 0 ? CONV_P1_ITEMS : CONV_P8_ITEMS); it += ngw) {
            ConvSel s; s.found = false; s.W = nullptr; s.W2 = nullptr; s.gain = nullptr; s.WT = nullptr; s.ldw = 0; s.K = 64; s.ndst = 32; s.map = 0; s.item = 0; int r = it;
            if (which == 0) {
                CJ(args.in[IN_F1D], nullptr, nullptr, DM, FF, DM, MAP_PLAIN, (bf16_t*)(ws + WS_W1D))
                CJ(args.in[IN_WIN], nullptr, args.in[IN_MIXN], NIN, DM, NIN, MAP_WIN, (bf16_t*)(ws + WS_WIN))
            } else {
                CJ(args.in[IN_F2D], nullptr, nullptr, DM, FF, DM, MAP_PLAIN, (bf16_t*)(ws + WS_W2D))
                CJ(args.in[IN_PLEG], nullptr, args.in[IN_PLEN], DM, DM, DM, MAP_PLAIN, (bf16_t*)(ws + WS_WPG))
                CJ(args.in[IN_PLEP], nullptr, nullptr, DM, PLE, DM, MAP_PLAIN, (bf16_t*)(ws + WS_WPP))
            }
            conv_item(s.W, s.W2, s.gain, s.ldw, s.K, s.ndst, s.map, s.WT, s.item, scr, c.lane);
        }
        if (which == 1) {
            bf16_t* pb = (bf16_t*)(ws + WS_PB);
            for (int e = (c.bx - 128) * 512 + c.tid; e < T * PLE / 8; e += 128 * 512) {
                const f32x4 a = *(const f32x4*)(args.in[IN_P] + (size_t)e * 8), d = *(const f32x4*)(args.in[IN_P] + (size_t)e * 8 + 4);
                u32x4 wq; wq[0] = pk2(a[0], a[1]); wq[1] = pk2(a[2], a[3]); wq[2] = pk2(d[0], d[1]); wq[3] = pk2(d[2], d[3]);
                *(u32x4*)(pb + (size_t)e * 8) = wq;
            }
        }
    }
}
__device__ __forceinline__ void phase_resid(const Ctx& c, const bf16_t* A, int K, size_t ws_w, const float* xold, float* xnew, float coef) {
    pg8::Gemm g{A, (const bf16_t*)(c.ws + ws_w), K, K, T, DM, K};
    pg8::StaticOrder S; S.init(T, DM, c.G, c.bx);
    pg8::EpiResid E{xold, xnew, (bf16_t*)(c.ws + WS_XB), (float*)(c.ws + WS_SSQ), coef};
    pg8::gemm_phase<pg8::EpiResid, pg8::StaticOrder, false, true>(c.lds, g, S, E);
}
__device__ __forceinline__ void phase_win(const Args& args, const Ctx& c) {
    pg8::Gemm g{(const bf16_t*)(c.ws + WS_XB), (const bf16_t*)(c.ws + WS_WIN), DM, DM, T, NIN, DM};
    pg8::StaticOrder S; S.init(T, NIN, c.G, c.bx);
    pg8::EpiWin E{(const float*)(c.ws + WS_SSQ), (bf16_t*)(c.ws + WS_D), (bf16_t*)(c.ws + WS_C), (bf16_t*)(c.ws + WS_GATE), (const float*)(c.ws + WS_COS), (const float*)(c.ws + WS_SIN), args.in[IN_QN], args.in[IN_KN]};
    pg8::gemm_phase<pg8::EpiWin, pg8::StaticOrder, ALIGN_MULTI, true>(c.lds, g, S, E);
}
template <class BarT>
__device__ __forceinline__ void phase_mixers(const Args& args, const Ctx& c, const BarT& gb, int mode = 0) {
    if (mode != 2) { rwkv_chunked(args, c.ws, c.bx >> 5, (c.bx >> 2) & 7, c.bx & 3, c.lds, gb); __syncthreads(); }
    if (mode != 1) {
        bf16_t* qkv = (bf16_t*)(c.ws + WS_C);
        float gq = fabsf(args.in[IN_QN][c.lane]), gk = fabsf(args.in[IN_KN][c.lane]);
#pragma unroll
        for (int o = 1; o < 64; o <<= 1) { gq = fmaxf(gq, __shfl_xor(gq, o)); gk = fmaxf(gk, __shfl_xor(gk, o)); }
        const float negbound = -(8.0f * 1.4426950408889634f) * gq * gk;
        for (int it = c.gw; it < NB * NAH * 64; it += c.NGW)
            attn_item(qkv, qkv + QKV_SEC, qkv + 2 * QKV_SEC, (float*)(c.ws + WS_ATL), it, negbound, c.lds + c.wave * 4096, c.lane, mode != 2);
    }
}
__device__ __forceinline__ void phase_combine_late(const Args& args, const Ctx& c) {
    unsigned char* ws = c.ws;
    const bf16_t* qkv = (const bf16_t*)(ws + WS_C); const float* atl = (const float*)(ws + WS_ATL); bf16_t* ycat = (bf16_t*)(ws + WS_XB);
    for (int e = c.bx * 512 + c.tid; e < T * 32; e += c.G * 512) {
        const int t = e >> 5, j = (e >> 3) & 3, c8 = e & 7, b = t >> 11, s = t & 2047;
        float num[8] = {0.f, 0.f, 0.f, 0.f, 0.f, 0.f, 0.f, 0.f}; float den = 0.f;
#pragma unroll
        for (int g = 0; g < 3; ++g) {
            const int sh = 2 * g, idx = ((s & ((1 << sh) - 1)) << (11 - sh)) + (s >> sh);
            const size_t off = (size_t)(b * NAH + 4 * g + j) * SEQ + idx;
            const u32x4 q = *(const u32x4*)(qkv + off * HD + 8 * c8); float f[8]; unpack8(q, f);
#pragma unroll
            for (int i = 0; i < 8; ++i) num[i] += f[i];
            den += atl[off];
        }
        const float inv = 1.0f / den;
        u32x4 wq; wq[0] = pk2(num[0] * inv, num[1] * inv); wq[1] = pk2(num[2] * inv, num[3] * inv); wq[2] = pk2(num[4] * inv, num[5] * inv); wq[3] = pk2(num[6] * inv, num[7] * inv);
        *(u32x4*)(ycat + (size_t)t * YC + 512 + 64 * j + 8 * c8) = wq;
    }
    LAS float* scr = (LAS float*)(c.lds + c.wave * 16384);
    for (int it = c.gw; it < CONV_LATE_ITEMS; it += c.NGW) {
        ConvSel s; s.found = false; s.W = nullptr; s.W2 = nullptr; s.gain = nullptr; s.WT = nullptr; s.ldw = 0; s.K = 64; s.ndst = 32; s.map = 0; s.item = 0; int r = it;
        CJ(args.in[IN_F2G], args.in[IN_F2U], args.in[IN_F2N], FF, DM, 2 * FF, MAP_CAT, (bf16_t*)(ws + WS_W2CAT))
        CJ(args.in[IN_BRR], nullptr, nullptr, DM, RWD, DM, MAP_PLAIN, (bf16_t*)(ws + WS_WBRA))
        CJ(args.in[IN_BRA], nullptr, nullptr, DM, 256, DM, MAP_PLAIN, (bf16_t*)(ws + WS_WBRB))
        CJ(args.in[IN_WOUT], nullptr, nullptr, DM, DM, DM, MAP_PLAIN, (bf16_t*)(ws + WS_WOUT))
        conv_item(s.W, s.W2, s.gain, s.ldw, s.K, s.ndst, s.map, s.WT, s.item, scr, c.lane);
    }
}
__device__ __forceinline__ void phase_gate_gemm(const Ctx& c, const bf16_t* A, int lda, int K, size_t ws_w, bf16_t* O, const bf16_t* gate, int goff, const bf16_t* addp) {
    pg8::Gemm g{A, (const bf16_t*)(c.ws + ws_w), lda, K, T, DM, K};
    pg8::StaticOrder S; S.init(T, DM, c.G, c.bx);
    pg8::EpiGateBf16 E{O, gate, goff, addp};
    pg8::gemm_phase<pg8::EpiGateBf16, pg8::StaticOrder, false, true>(c.lds, g, S, E);
    asm volatile("s_waitcnt vmcnt(0)" ::: "memory"); __syncthreads();
}
__device__ __forceinline__ void phase_ple(const Args& args, const Ctx& c, float* outp) {
    pg8::Gemm g{(const bf16_t*)(c.ws + WS_XB), (const bf16_t*)(c.ws + WS_WPG), DM, DM, T, DM, DM};
    pg8::StaticOrder S; S.init(T, DM, c.G, c.bx);
    pg8::EpiPle E{args.out, outp, (const float*)(c.ws + WS_SSQ), (const bf16_t*)(c.ws + WS_C)};
    pg8::gemm_phase<pg8::EpiPle, pg8::StaticOrder, false, true>(c.lds, g, S, E);
}

__global__ void __launch_bounds__(NWAVES * 64, 2) mk_fwd(Args args) {
    extern __shared__ __attribute__((aligned(16))) unsigned char lds_raw[];
    Ctx c;
    c.lds = (LAS unsigned char*)lds_raw; c.ws = args.ws;
    c.tid = threadIdx.x; c.lane = c.tid & 63; c.wave = __builtin_amdgcn_readfirstlane(c.tid >> 6);
    c.G = gridDim.x; c.bx = blockIdx.x; c.gw = c.bx * NWAVES + c.wave; c.NGW = c.G * NWAVES;
    volatile LAS unsigned* MISC = (volatile LAS unsigned*)(c.lds + MISC_OFF);
    for (int u = c.tid; u < (LDS_BYTES - RING_BYTES) / 4; u += NWAVES * 64) ((LAS unsigned*)(c.lds + RING_BYTES))[u] = 0u;
    __syncthreads();
#if MK_ONE_LAUNCH
    XcdBarrier bar = xcd_barrier_post((unsigned*)(c.ws + WS_CTL) + 4096, MISC + 8);
#define GRID_BAR() xcd_barrier(bar)
    const GridBarFn gbar{bar};
#else
#error "the chunked rwkv phase needs the in-kernel grid barrier: build with MK_ONE_LAUNCH=1"
#endif
    const int lo = args.ph_lo, hi = args.ph_hi;
#define IN(k) (lo <= (k) && (k) < hi)
#define SEAM(k) do { if (IN(k) && IN((k) + 1)) GRID_BAR(); } while (0)
    unsigned char* ws = c.ws;
    bf16_t* hU = (bf16_t*)(ws + WS_C); bf16_t* merged = (bf16_t*)(ws + WS_C); bf16_t* m1 = (bf16_t*)(ws + WS_M1); bf16_t* pp = (bf16_t*)(ws + WS_C);
    bf16_t* ycat = (bf16_t*)(ws + WS_XB); const bf16_t* gates = (const bf16_t*)(ws + WS_GATE);

#ifndef PROBE_REP
#define PROBE_REP -1
#endif
    float* dummyf = (float*)(ws + 76 * MiB);
    if (EN0 && IN(0)) { phase_prologue(args, c); if (PROBE_REP == 0) { GRID_BAR(); phase_prologue(args, c); } }
    SEAM(0);
    if (EN1 && IN(1)) { phase_swiglu(args, c, WS_W1CAT, 0); if (PROBE_REP == 1) { GRID_BAR(); phase_swiglu(args, c, WS_W1CAT, 0); } }
    SEAM(1);
    if (EN2 && IN(2)) { phase_resid(c, hU, FF, WS_W1D, args.in[IN_X], args.out, 0.5f); if (PROBE_REP == 2) { GRID_BAR(); phase_resid(c, hU, FF, WS_W1D, args.in[IN_X], args.out, 0.5f); } }
    SEAM(2);
    if (EN3 && IN(3)) { phase_win(args, c); if (PROBE_REP == 3) { GRID_BAR(); phase_win(args, c); } }
    SEAM(3);
    if (EN4 && IN(4)) { if (PROBE_REP == 41) { phase_mixers(args, c, gbar, 1); GRID_BAR(); } if (PROBE_REP == 42) { phase_mixers(args, c, gbar, 2); GRID_BAR(); } phase_mixers(args, c, gbar, 0); }
    SEAM(4);
    if (EN5 && IN(5)) { phase_combine_late(args, c); if (PROBE_REP == 5) { GRID_BAR(); phase_combine_late(args, c); } }
    SEAM(5);
    if (EN6 && IN(6)) {
        for (int rep = 0; rep < (PROBE_REP == 6 ? 2 : 1); ++rep) {
        phase_gate_gemm(c, ycat, YC, RWD, WS_WBRA, m1, gates, 0, nullptr);
        phase_gate_gemm(c, ycat + 512, YC, 256, WS_WBRB, merged, gates, DM, m1);
        if (PROBE_REP == 6 && rep == 0) GRID_BAR(); }
    }
    SEAM(6);
    if (EN2 && IN(7)) { if (PROBE_REP == 7) { phase_resid(c, merged, DM, WS_WOUT, args.out, dummyf, 1.0f); GRID_BAR(); } phase_resid(c, merged, DM, WS_WOUT, args.out, args.out, 1.0f); }
    SEAM(7);
    if (EN1 && IN(8)) phase_swiglu(args, c, WS_W2CAT, 1);
    SEAM(8);
    if (EN2 && IN(9)) phase_resid(c, hU, FF, WS_W2D, args.out, args.out, 0.5f);
    SEAM(9);
    if (EN10 && IN(10)) {
        phase_gate_gemm(c, (const bf16_t*)(ws + WS_PB), PLE, PLE, WS_WPP, pp, nullptr, 0, nullptr);
        if (PROBE_REP == 101) { GRID_BAR(); phase_gate_gemm(c, (const bf16_t*)(ws + WS_PB), PLE, PLE, WS_WPP, pp, nullptr, 0, nullptr); }
        if (PROBE_REP == 102) { phase_ple(args, c, dummyf); GRID_BAR(); }
        phase_ple(args, c, args.out);
    }
    if (PROBE_REP == 99) { for (int i = 0; i < 10; ++i) GRID_BAR(); }
}

extern "C" void kernel_launch(void* const* d_in, const int* in_sizes, int n_in, void* d_out, int out_size, void* d_ws, size_t ws_size, hipStream_t stream) {
    static int grid = 0;
    if (grid == 0) {
        if (n_in != 32 || in_sizes[0] != T * DM || out_size != T * DM || ws_size < WS_END) { fprintf(stderr, "kernel_launch: unexpected problem shape (n_in %d, in0 %d, out %d, ws %zu); nothing launched\n", n_in, n_in > 0 ? in_sizes[0] : -1, out_size, ws_size); grid = -1; return; }
        int dev = 0, cus = 0, per_cu = 0;
        if (hipGetDevice(&dev) != hipSuccess || hipDeviceGetAttribute(&cus, hipDeviceAttributeMultiprocessorCount, dev) != hipSuccess) { grid = -1; return; }
        if (hipFuncSetAttribute((const void*)mk_fwd, hipFuncAttributeMaxDynamicSharedMemorySize, LDS_BYTES) != hipSuccess) { fprintf(stderr, "kernel_launch: hipFuncSetAttribute failed\n"); grid = -1; return; }
        if (hipOccupancyMaxActiveBlocksPerMultiprocessor(&per_cu, (const void*)mk_fwd, NWAVES * 64, LDS_BYTES) != hipSuccess || per_cu < 1) { fprintf(stderr, "kernel_launch: occupancy query reports %d workgroups per CU\n", per_cu); }
        (void)hipGetLastError();
        grid = cus;
        if (grid != 256) fprintf(stderr, "kernel_launch: %d CUs; this kernel is built for a 256-CU device\n", grid);
    }
    if (grid < 0) return;
    (void)hipMemsetAsync((char*)d_ws + WS_CTL, 0, CTL_ZERO_BYTES, stream);
    Args a{};
    for (int i = 0; i < 32; ++i) a.in[i] = (const float*)d_in[i];
    a.out = (float*)d_out; a.ws = (unsigned char*)d_ws;
#if MK_ONE_LAUNCH
    a.ph_lo = 0; a.ph_hi = N_PHASES; a.li = 0;
    hipLaunchKernelGGL(mk_fwd, dim3(grid), dim3(NWAVES * 64), LDS_BYTES, stream, a);
#else
    for (int ph = 0; ph < N_PHASES; ++ph) {
        a.ph_lo = ph; a.ph_hi = ph + 1; a.li = ph;
        hipLaunchKernelGGL(mk_fwd, dim3(grid), dim3(NWAVES * 64), LDS_BYTES, stream, a);
    }
#endif
    const hipError_t le = hipPeekAtLastError();
    if (le != hipSuccess) fprintf(stderr, "kernel_launch: launch failed: %s\n", hipGetErrorName(le));
}
```
